# Optimizing an MI355X kernel written in HIP

```python
import math
import jax, jax.numpy as jnp
from jax import lax
import numpy as np

D_MODEL = 1024
BATCH = 16
SEQ = 2048
DEPTH = 4

CHUNK = 64
Q_BLOCK = 128
N_HEADS = 8
QK_NOPE = 64
QK_ROPE = 32
V_HEAD = 64
Q_LORA = 384
KV_LORA = 256
ROPE_THETA = 10000.0
SSM_WIDTH = 512
SSM_GROUP = 16
SSM_GROUPS = SSM_WIDTH // SSM_GROUP
SSM_STATE = 64
DT_MIN = 1e-3
DT_MAX = 1e-1
D_FF = 2816
CONV_W = 3
EPS = 1e-6
N_BRANCH = 2
IN_COLS = Q_LORA + KV_LORA + QK_ROPE + SSM_WIDTH + N_BRANCH * D_MODEL

kernel_name = "hybrid_mla_s5_convglu_trunk"


def rmsnorm(x, g):
    xf = x.astype(jnp.float32)
    var = jnp.mean(xf * xf, axis=-1, keepdims=True)
    return (xf * lax.rsqrt(var + EPS) * g.astype(jnp.float32)).astype(x.dtype)


def rope_tables(seq):
    pos = jnp.arange(seq, dtype=jnp.float32)
    inv_freq = ROPE_THETA ** (-jnp.arange(0, QK_ROPE, 2, dtype=jnp.float32) / QK_ROPE)
    ang = pos[:, None] * inv_freq[None, :]
    return jnp.cos(ang), jnp.sin(ang)


def apply_rope(x, cos, sin):
    xf = x.astype(jnp.float32)
    x1, x2 = jnp.split(xf, 2, axis=-1)
    out = jnp.concatenate([x1 * cos - x2 * sin, x2 * cos + x1 * sin], axis=-1)
    return out.astype(x.dtype)


def mla_branch(c_q, c_kv, k_pe, g_q, w_uq, g_kv, w_ukv, w_o_att, cos, sin):
    b, s, _ = c_q.shape
    q = (rmsnorm(c_q, g_q) @ w_uq).reshape(b, s, N_HEADS, QK_NOPE + QK_ROPE)
    q_nope, q_pe = q[..., :QK_NOPE], q[..., QK_NOPE:]
    q_pe = apply_rope(q_pe, cos[None, :, None, :], sin[None, :, None, :])
    kv = (rmsnorm(c_kv, g_kv) @ w_ukv).reshape(b, s, N_HEADS, QK_NOPE + V_HEAD)
    k_nope, v = kv[..., :QK_NOPE], kv[..., QK_NOPE:]
    k_pe = apply_rope(k_pe, cos[None], sin[None])
    scale = 1.0 / math.sqrt(QK_NOPE + QK_ROPE)
    outs = []
    for i in range(s // Q_BLOCK):
        q0 = i * Q_BLOCK
        kend = q0 + Q_BLOCK
        sc = (jnp.einsum('bqhd,bkhd->bhqk', q_nope[:, q0:kend], k_nope[:, :kend])
              + jnp.einsum('bqhr,bkr->bhqk', q_pe[:, q0:kend], k_pe[:, :kend]))
        sc = sc.astype(jnp.float32) * scale
        q_chunk = (q0 + jnp.arange(Q_BLOCK)) // CHUNK
        k_chunk = jnp.arange(kend) // CHUNK
        mask = q_chunk[:, None] >= k_chunk[None, :]
        sc = jnp.where(mask[None, None], sc, -jnp.inf)
        p = jax.nn.softmax(sc, axis=-1).astype(v.dtype)
        outs.append(jnp.einsum('bhqk,bkhd->bqhd', p, v[:, :kend]))
    o = jnp.concatenate(outs, axis=1).reshape(b, s, N_HEADS * V_HEAD)
    return o @ w_o_att


def s5_combine(e1, e2):
    a1r, a1i, b1r, b1i = e1
    a2r, a2i, b2r, b2i = e2
    return (a2r * a1r - a2i * a1i,
            a2r * a1i + a2i * a1r,
            a2r * b1r - a2i * b1i + b2r,
            a2r * b1i + a2i * b1r + b2i)


def s5_branch(u, lam_re, lam_im, log_step, b_re, b_im, c_re, c_im, d_skip, w_glu):
    b, s, _ = u.shape
    u32 = u.astype(jnp.float32)
    ug = u32.reshape(b, s, SSM_GROUPS, SSM_GROUP)
    lr = lam_re.astype(jnp.float32)
    li = lam_im.astype(jnp.float32)
    delta = jnp.exp(log_step.astype(jnp.float32))[:, None]
    mag = jnp.exp(lr * delta)
    abar_re = mag * jnp.cos(li * delta)
    abar_im = mag * jnp.sin(li * delta)
    nr, ni = abar_re - 1.0, abar_im
    den = lr * lr + li * li
    f_re = (nr * lr + ni * li) / den
    f_im = (ni * lr - nr * li) / den
    br, bi = b_re.astype(jnp.float32), b_im.astype(jnp.float32)
    bbar_re = f_re[..., None] * br - f_im[..., None] * bi
    bbar_im = f_re[..., None] * bi + f_im[..., None] * br
    bu_re = jnp.einsum('bsgh,gph->bsgp', ug, bbar_re)
    bu_im = jnp.einsum('bsgh,gph->bsgp', ug, bbar_im)
    a_re = jnp.broadcast_to(abar_re[None, None], (1, s, SSM_GROUPS, SSM_STATE))
    a_im = jnp.broadcast_to(abar_im[None, None], (1, s, SSM_GROUPS, SSM_STATE))
    _, _, xr, xi = lax.associative_scan(s5_combine, (a_re, a_im, bu_re, bu_im), axis=1)
    y = (jnp.einsum('bsgp,ghp->bsgh', xr, c_re.astype(jnp.float32))
         - jnp.einsum('bsgp,ghp->bsgh', xi, c_im.astype(jnp.float32)))
    y = y.reshape(b, s, SSM_WIDTH) + d_skip.astype(jnp.float32) * u32
    y = jax.nn.gelu(y).astype(u.dtype)
    ga, gb = jnp.split(y @ w_glu, 2, axis=-1)
    return ga * jax.nn.sigmoid(gb)


def conv_glu_ffn(h, w_up, conv_w, conv_b, w_down):
    s = h.shape[1]
    gate, val = jnp.split(h @ w_up, 2, axis=-1)
    padded = jnp.pad(gate, ((0, 0), (CONV_W - 1, 0), (0, 0)))
    conv = conv_b
    for k in range(CONV_W):
        conv = conv + conv_w[k] * padded[:, k:k + s]
    return (jax.nn.gelu(conv) * val) @ w_down


def setup_inputs(seed: int = 0) -> dict:
    key = jax.random.key(seed)
    ks = jax.random.split(key, 24)
    f32 = jnp.float32
    nrm = lambda k, shape, sc: jax.random.normal(k, shape, f32) * sc
    gain = lambda k, dim: 1.0 + 0.05 * jax.random.normal(k, (DEPTH, dim), f32)
    n_idx = jnp.arange(SSM_STATE, dtype=f32)
    return {
        "x": jax.random.normal(ks[0], (BATCH, SEQ, D_MODEL), f32),
        "w_in": nrm(ks[1], (DEPTH, D_MODEL, IN_COLS), D_MODEL ** -0.5),
        "b_gate": nrm(ks[2], (DEPTH, N_BRANCH * D_MODEL), 0.1),
        "g_mix_pre": gain(ks[3], D_MODEL),
        "g_q": gain(ks[4], Q_LORA),
        "w_uq": nrm(ks[5], (DEPTH, Q_LORA, N_HEADS * (QK_NOPE + QK_ROPE)), Q_LORA ** -0.5),
        "g_kv": gain(ks[6], KV_LORA),
        "w_ukv": nrm(ks[7], (DEPTH, KV_LORA, N_HEADS * (QK_NOPE + V_HEAD)), KV_LORA ** -0.5),
        "w_o_att": nrm(ks[8], (DEPTH, N_HEADS * V_HEAD, D_MODEL), (N_HEADS * V_HEAD) ** -0.5),
        "lam_re": -0.5 + 0.01 * jax.random.normal(ks[9], (DEPTH, SSM_GROUPS, SSM_STATE), f32),
        "lam_im": math.pi * n_idx + 0.01 * jax.random.normal(ks[10], (DEPTH, SSM_GROUPS, SSM_STATE), f32),
        "log_step": jax.random.uniform(ks[11], (DEPTH, SSM_GROUPS), f32,
                                       math.log(DT_MIN), math.log(DT_MAX)),
        "b_re": nrm(ks[12], (DEPTH, SSM_GROUPS, SSM_STATE, SSM_GROUP), (2 * SSM_GROUP) ** -0.5),
        "b_im": nrm(ks[13], (DEPTH, SSM_GROUPS, SSM_STATE, SSM_GROUP), (2 * SSM_GROUP) ** -0.5),
        "c_re": nrm(ks[14], (DEPTH, SSM_GROUPS, SSM_GROUP, SSM_STATE), (2 * SSM_STATE) ** -0.5),
        "c_im": nrm(ks[15], (DEPTH, SSM_GROUPS, SSM_GROUP, SSM_STATE), (2 * SSM_STATE) ** -0.5),
        "d_skip": nrm(ks[16], (DEPTH, SSM_WIDTH), 1.0),
        "w_glu": nrm(ks[17], (DEPTH, SSM_WIDTH, 2 * D_MODEL), SSM_WIDTH ** -0.5),
        "w_out": nrm(ks[18], (DEPTH, D_MODEL, D_MODEL), D_MODEL ** -0.5),
        "g_mix_post": gain(ks[19], D_MODEL),
        "g_ffn_pre": gain(ks[20], D_MODEL),
        "w_up": nrm(ks[21], (DEPTH, D_MODEL, 2 * D_FF), D_MODEL ** -0.5),
        "conv_w": nrm(ks[22], (DEPTH, CONV_W, D_FF), CONV_W ** -0.5),
        "conv_b": nrm(ks[23], (DEPTH, D_FF), 0.02),
        "w_down": nrm(jax.random.fold_in(key, 101), (DEPTH, D_FF, D_MODEL), D_FF ** -0.5),
        "g_ffn_post": gain(jax.random.fold_in(key, 102), D_MODEL),
    }


def reference(x, w_in, b_gate, g_mix_pre, g_q, w_uq, g_kv, w_ukv, w_o_att,
              lam_re, lam_im, log_step, b_re, b_im, c_re, c_im, d_skip, w_glu,
              w_out, g_mix_post, g_ffn_pre, w_up, conv_w, conv_b, w_down, g_ffn_post):
    s = x.shape[1]
    cos, sin = rope_tables(s)
    o1 = Q_LORA
    o2 = o1 + KV_LORA
    o3 = o2 + QK_ROPE
    o4 = o3 + SSM_WIDTH
    for l in range(DEPTH):
        h = rmsnorm(x, g_mix_pre[l])
        z = h @ w_in[l]
        c_q, c_kv, k_pe, u = z[..., :o1], z[..., o1:o2], z[..., o2:o3], z[..., o3:o4]
        gates = jax.nn.sigmoid((z[..., o4:] + b_gate[l]).astype(jnp.float32)).astype(x.dtype)
        g_att, g_ssm = gates[..., :D_MODEL], gates[..., D_MODEL:]
        y_att = mla_branch(c_q, c_kv, k_pe, g_q[l], w_uq[l], g_kv[l], w_ukv[l],
                           w_o_att[l], cos, sin)
        y_ssm = s5_branch(u, lam_re[l], lam_im[l], log_step[l], b_re[l], b_im[l],
                          c_re[l], c_im[l], d_skip[l], w_glu[l])
        merged = g_att * y_att + g_ssm * y_ssm
        x = x + rmsnorm(merged @ w_out[l], g_mix_post[l])
        h = rmsnorm(x, g_ffn_pre[l])
        x = x + rmsnorm(conv_glu_ffn(h, w_up[l], conv_w[l], conv_b[l], w_down[l]), g_ffn_post[l])
    return x
```

```cpp
#include <hip/hip_runtime.h>
#include <hip/hip_cooperative_groups.h>
#include <cstdio>
#include <cstdint>
namespace cg = cooperative_groups;

#define LAS __attribute__((address_space(3)))
#define PG8_LAS __attribute__((address_space(3)))
typedef unsigned short bf16_t;
typedef short bf16x8 __attribute__((ext_vector_type(8)));
typedef short s16x4 __attribute__((ext_vector_type(4)));
typedef float f32x4 __attribute__((ext_vector_type(4)));
typedef float f32x2 __attribute__((ext_vector_type(2)));
typedef unsigned u32x4 __attribute__((ext_vector_type(4)));
typedef unsigned u32x2 __attribute__((ext_vector_type(2)));

constexpr int T_TOK = 32768, DM = 1024, SEQ = 2048, NBATCH = 16, DEPTH = 4;
constexpr int QL = 384, KVL = 256, ROPE_D = 32, SSMW = 512, INC = 3232, INP = 3328;
constexpr int NHEAD = 8, QKD = 96, DFF = 2816;
constexpr int LCH = 32, NCHR = T_TOK / LCH  , KS5 = 640, NGRP = 32, NST = 64;
constexpr float EPS = 1e-6f;

constexpr int BM = 256, BK = 64, HALF = 128, HTB = HALF * BK * 2, STAGE_BYTES = 8 * HTB, NXCD = 8, WGM = 8;

__host__ __device__ __forceinline__ int lds_byte(int r, int c) { const int st = (r >> 4) * 2 + (c >> 5), rr = r & 15, cc = c & 31, ob = rr * 64 + cc * 2; return st * 1024 + (ob ^ (((ob >> 9) & 1) << 5)); }
__host__ __device__ __forceinline__ void stage_rc(int b, int& R, int& C) { const int st = b / 1024, sb = b % 1024, swz = sb ^ (((sb >> 9) & 1) << 5); R = (st >> 1) * 16 + swz / 64; C = (st & 1) * 32 + (swz % 64) / 2; }
__host__ __device__ __forceinline__ int perm32(int rho) { const int n = rho >> 4, i = rho & 15; return 8 * (i >> 2) + 4 * n + (i & 3); }

struct Unit { int pm, pn, z; };
struct Gemm { const bf16_t* A; const bf16_t* Bt; int lda, ldb, K; size_t zA, zB; };

struct StaticOrder {
    int nM, nN, nwg, G, c;
    __host__ __device__ void init(int M, int N, int G_, int c_) { nM = M / BM; nN = N / BM; nwg = nM * nN; G = G_; c = c_; }
    __host__ __device__ bool next(int i, Unit& u) const {
        const long L = (long)i * G + c; if (L >= nwg) return false;
        int wgid = (int)L; { const int q = nwg / NXCD, r = nwg % NXCD, xcd = wgid % NXCD, off = wgid / NXCD; wgid = (xcd < r ? xcd * (q + 1) : r * (q + 1) + (xcd - r) * q) + off; }
        const int nig = WGM * nN, gid = wgid / nig, fm = gid * WGM, gsz = (nM - fm) < WGM ? (nM - fm) : WGM;
        u.pm = fm + ((wgid % nig) % gsz); u.pn = (wgid % nig) / gsz; u.z = 0; return true;
    }
    __device__ __forceinline__ void a_ready(const Unit&) const {}
    __device__ __forceinline__ void done(const Unit&) const {}
};
struct BatchOrder {
    int nM, nN, nz, G, c;
    __host__ __device__ void init(int M, int N, int nz_, int G_, int c_) { nM = M / BM; nN = N / BM; nz = nz_; G = G_; c = c_; }
    __host__ __device__ bool next(int i, Unit& u) const {
        const long L = (long)i * G + c; if (L >= (long)nz * nM * nN) return false;
        const int per = nM * nN; u.z = (int)(L / per); const int r = (int)(L % per); u.pn = r / nM; u.pm = r % nM; return true;
    }
    __device__ __forceinline__ void a_ready(const Unit&) const {}
    __device__ __forceinline__ void done(const Unit&) const {}
};

typedef __bf16 bf16x2_t __attribute__((ext_vector_type(2)));
__device__ __forceinline__ unsigned cvt_pk_bf16(float lo, float hi) { const f32x2 v = {lo, hi}; const bf16x2_t b = __builtin_convertvector(v, bf16x2_t); return __builtin_bit_cast(unsigned, b); }
__device__ __forceinline__ float bf_lo(unsigned w) { return __uint_as_float(w << 16); }
__device__ __forceinline__ float bf_hi(unsigned w) { return __uint_as_float(w & 0xffff0000u); }
__device__ __forceinline__ float shx(float x, int k, int lane) { return __builtin_bit_cast(float, __builtin_amdgcn_ds_bpermute((lane ^ k) << 2, __builtin_bit_cast(int, x))); }
__device__ __forceinline__ float sigmoid_f(float x) { return __builtin_amdgcn_rcpf(1.0f + __builtin_amdgcn_exp2f(x * -1.4426950408889634f)); }
__device__ __forceinline__ float gelu_tanh(float x) {
    const float K1 = 2.0f * 0.7978845608028654f * 1.4426950408889634f, K2 = K1 * 0.044715f;
    const float a = fmaf(x * x, K2, K1); return x * __builtin_amdgcn_rcpf(1.0f + __builtin_amdgcn_exp2f(-x * a)); }
__device__ __forceinline__ u32x4 pack8(const f32x4 a, const f32x4 b) { u32x4 w; w.x = cvt_pk_bf16(a[0], a[1]); w.y = cvt_pk_bf16(a[2], a[3]); w.z = cvt_pk_bf16(b[0], b[1]); w.w = cvt_pk_bf16(b[2], b[3]); return w; }

template <class Epi, class Sched, bool ALIGN_EPI = false, bool SP2 = false>
__device__ __forceinline__ void gemm_phase(PG8_LAS unsigned char* lds, const Gemm g, const Sched& S, const Epi& E) {
    int tid_o = threadIdx.x; asm volatile("" : "+v"(tid_o));
    const int tid = tid_o, wid = __builtin_amdgcn_readfirstlane(tid >> 6), lane = tid & 63, wr = wid >> 2, wc = wid & 3, fr = lane & 15, fq = lane >> 4;
    const int K = g.K, nt = K / BK;
    unsigned voffA[2], voffB[2];
#pragma unroll
    for (int i = 0; i < 2; ++i) { int R, C; stage_rc(tid * 16 + i * 8192, R, C); const int Rb = Epi::PERM ? ((R & ~31) + perm32(R & 31)) : R;
        voffA[i] = (unsigned)(R * g.lda + C) * 2u; voffB[i] = (unsigned)(Rb * g.ldb + C) * 2u; }
    const size_t kstep = (size_t)(BK * 2);
    const size_t hstepA = (size_t)HALF * g.lda * 2, hstepB = (size_t)HALF * g.ldb * 2;
    const size_t tstepA = 2 * hstepA, tstepB = 2 * hstepB;
    const unsigned ldsw = (unsigned)wid * 1024u;
    const int aoff = lds_byte(wr * 64 + fr, fq * 8), boff = lds_byte(wc * 32 + fr, fq * 8);
#define PG8_SA(b, h) (((b) * 2 + (h)) * HTB)
#define PG8_SB(b, h) ((4 + (b) * 2 + (h)) * HTB)
#define PG8_STAGE(bufoff, gbase, voff) do { _Pragma("unroll") for (int _i = 0; _i < 2; ++_i) \
        __builtin_amdgcn_global_load_lds((const unsigned*)((const char*)(gbase) + (voff)[_i]), (PG8_LAS unsigned*)(lds + (bufoff) + ldsw + _i * 8192), 16, 0, 0); } while (0)
#define PG8_LDA(dst, b, h) do { _Pragma("unroll") for (int m = 0; m < 4; ++m) _Pragma("unroll") for (int k = 0; k < 2; ++k) dst[m][k] = *(const PG8_LAS bf16x8*)(lds + PG8_SA(b, h) + aoff + m * 2048 + k * 1024); } while (0)
#define PG8_LDB(dst, b, h) do { _Pragma("unroll") for (int n = 0; n < 2; ++n) _Pragma("unroll") for (int k = 0; k < 2; ++k) dst[n][k] = *(const PG8_LAS bf16x8*)(lds + PG8_SB(b, h) + boff + n * 2048 + k * 1024); } while (0)
#define PG8_MMA(ai, bj, At, Bt) do { __builtin_amdgcn_s_setprio(1); _Pragma("unroll") for (int m = 0; m < 4; ++m) _Pragma("unroll") for (int n = 0; n < 2; ++n) _Pragma("unroll") for (int k = 0; k < 2; ++k) \
        acc[ai][bj][m][n] = __builtin_amdgcn_mfma_f32_16x16x32_bf16(Bt[n][k], At[m][k], acc[ai][bj][m][n], 0, 0, 0); __builtin_amdgcn_s_setprio(0); } while (0)
#define PG8_WAIT_V(n) asm volatile("s_waitcnt vmcnt(" #n ")" ::: "memory")
#define PG8_WAIT_L(n) asm volatile("s_waitcnt lgkmcnt(" #n ")" ::: "memory")
#define PG8_BAR __builtin_amdgcn_s_barrier()
#define PG8_SCHED __builtin_amdgcn_sched_barrier(0)
    Unit cur, nxt; int ui = 0;
    if (!S.next(0, cur)) return;
    f32x4 acc[2][2][4][2];
#pragma unroll
    for (int a = 0; a < 2; ++a)
#pragma unroll
        for (int b = 0; b < 2; ++b)
#pragma unroll
            for (int m = 0; m < 4; ++m)
#pragma unroll
                for (int n = 0; n < 2; ++n) acc[a][b][m][n] = (f32x4){0.f, 0.f, 0.f, 0.f};
    bf16x8 At[4][2], B0[2][2], B1[2][2];
    const char* cA = (const char*)g.A + (size_t)cur.z * g.zA * 2 + (size_t)cur.pm * tstepA; const char* cB = (const char*)g.Bt + (size_t)cur.z * g.zB * 2 + (size_t)cur.pn * tstepB;
    S.a_ready(cur);
    if constexpr (SP2) {
        PG8_STAGE(PG8_SB(0, 0), cB, voffB); PG8_STAGE(PG8_SB(0, 1), cB + hstepB, voffB); PG8_STAGE(PG8_SA(0, 0), cA, voffA); PG8_STAGE(PG8_SA(0, 1), cA + hstepA, voffA);
        if (wr == 1) PG8_BAR;
        PG8_WAIT_V(2); PG8_BAR;
        PG8_STAGE(PG8_SB(1, 0), cB + kstep, voffB); PG8_STAGE(PG8_SA(1, 0), cA + kstep, voffA); PG8_STAGE(PG8_SB(1, 1), cB + hstepB + kstep, voffB);
        PG8_WAIT_V(6); PG8_BAR;
    } else {
        PG8_STAGE(PG8_SB(0, 0), cB, voffB); PG8_STAGE(PG8_SA(0, 0), cA, voffA); PG8_STAGE(PG8_SB(0, 1), cB + hstepB, voffB); PG8_STAGE(PG8_SA(0, 1), cA + hstepA, voffA);
        if (wr == 1) PG8_BAR;
        PG8_WAIT_V(4); PG8_BAR;
        PG8_STAGE(PG8_SB(1, 0), cB + kstep, voffB); PG8_STAGE(PG8_SA(1, 0), cA + kstep, voffA); PG8_STAGE(PG8_SB(1, 1), cB + hstepB + kstep, voffB);
        PG8_WAIT_V(6); PG8_BAR;
    }
    for (;;) {
        const bool has_next = S.next(ui + 1, nxt);
        const char* nA = has_next ? (const char*)g.A + (size_t)nxt.z * g.zA * 2 + (size_t)nxt.pm * tstepA : cA; const char* nB = has_next ? (const char*)g.Bt + (size_t)nxt.z * g.zB * 2 + (size_t)nxt.pn * tstepB : cB;
        for (int t = 0; t < nt; t += 2) {
            const bool last = (t == nt - 2);
            const char* a1 = cA + (size_t)(t + 1) * kstep;
            const char* a2 = last ? nA : cA + (size_t)(t + 2) * kstep; const char* b2 = last ? nB : cB + (size_t)(t + 2) * kstep;
            const char* a3 = a2 + kstep; const char* b3 = b2 + kstep;
            if (last && has_next) S.a_ready(nxt);
            if constexpr (SP2) {
            PG8_LDB(B0, 0, 0); PG8_LDB(B1, 0, 1); PG8_SCHED; PG8_LDA(At, 0, 0); PG8_STAGE(PG8_SA(1, 1), a1 + hstepA, voffA);
            PG8_WAIT_V(8); PG8_WAIT_L(0); PG8_BAR; PG8_MMA(0, 0, At, B0); PG8_MMA(0, 1, At, B1); PG8_BAR; PG8_SCHED;
            PG8_LDA(At, 0, 1); PG8_STAGE(PG8_SB(0, 0), b2, voffB); PG8_STAGE(PG8_SB(0, 1), b2 + hstepB, voffB); PG8_STAGE(PG8_SA(0, 0), a2, voffA);
            PG8_WAIT_V(8); PG8_WAIT_L(0); PG8_BAR; PG8_MMA(1, 0, At, B0); PG8_MMA(1, 1, At, B1); PG8_BAR; PG8_SCHED;
            PG8_LDB(B0, 1, 0); PG8_LDB(B1, 1, 1); PG8_SCHED; PG8_LDA(At, 1, 0); PG8_STAGE(PG8_SA(0, 1), a2 + hstepA, voffA);
            PG8_WAIT_V(8); PG8_WAIT_L(0); PG8_BAR; PG8_MMA(0, 0, At, B0); PG8_MMA(0, 1, At, B1); PG8_BAR; PG8_SCHED;
            PG8_LDA(At, 1, 1); PG8_STAGE(PG8_SB(1, 0), b3, voffB); PG8_STAGE(PG8_SB(1, 1), b3 + hstepB, voffB); PG8_STAGE(PG8_SA(1, 0), a3, voffA);
            PG8_WAIT_V(8); PG8_WAIT_L(0); PG8_BAR; PG8_MMA(1, 0, At, B0); PG8_MMA(1, 1, At, B1); PG8_BAR; PG8_SCHED;
            } else {
            PG8_LDB(B0, 0, 0); PG8_SCHED; PG8_LDA(At, 0, 0); PG8_STAGE(PG8_SA(1, 1), a1 + hstepA, voffA);
            PG8_WAIT_L(8); PG8_BAR; PG8_WAIT_L(0); PG8_MMA(0, 0, At, B0); PG8_BAR; PG8_SCHED;
            PG8_LDB(B1, 0, 1); PG8_STAGE(PG8_SB(0, 0), b2, voffB);
            PG8_BAR; PG8_WAIT_L(0); PG8_MMA(0, 1, At, B1); PG8_BAR;
            PG8_LDA(At, 0, 1); PG8_STAGE(PG8_SA(0, 0), a2, voffA);
            PG8_BAR; PG8_WAIT_L(0); PG8_MMA(1, 0, At, B0); PG8_BAR; PG8_SCHED;
            PG8_STAGE(PG8_SB(0, 1), b2 + hstepB, voffB);
            PG8_WAIT_V(6); PG8_BAR; PG8_MMA(1, 1, At, B1); PG8_BAR;
            PG8_LDB(B0, 1, 0); PG8_SCHED; PG8_LDA(At, 1, 0); PG8_STAGE(PG8_SA(0, 1), a2 + hstepA, voffA);
            PG8_WAIT_L(8); PG8_BAR; PG8_WAIT_L(0); PG8_MMA(0, 0, At, B0); PG8_BAR; PG8_SCHED;
            PG8_LDB(B1, 1, 1); PG8_STAGE(PG8_SB(1, 0), b3, voffB);
            PG8_BAR; PG8_WAIT_L(0); PG8_MMA(0, 1, At, B1); PG8_BAR;
            PG8_LDA(At, 1, 1); PG8_STAGE(PG8_SA(1, 0), a3, voffA);
            PG8_BAR; PG8_WAIT_L(0); PG8_MMA(1, 0, At, B0); PG8_BAR; PG8_SCHED;
            PG8_STAGE(PG8_SB(1, 1), b3 + hstepB, voffB);
            PG8_WAIT_V(6); PG8_BAR; PG8_MMA(1, 1, At, B1); PG8_BAR;
            }
        }
        if constexpr (ALIGN_EPI) { if (wr == 0) PG8_BAR; }
        if constexpr (!Epi::AFTER_DRAIN) { int lane_e; asm volatile("v_mbcnt_lo_u32_b32 %0, -1, 0\n\tv_mbcnt_hi_u32_b32 %0, -1, %0" : "=v"(lane_e)); E(acc, cur, wr, wc, lane_e & 15, lane_e >> 4); S.done(cur); }
        if (!has_next) break;
#pragma unroll
        for (int a = 0; a < 2; ++a)
#pragma unroll
            for (int b = 0; b < 2; ++b)
#pragma unroll
                for (int m = 0; m < 4; ++m)
#pragma unroll
                    for (int n = 0; n < 2; ++n) acc[a][b][m][n] = (f32x4){0.f, 0.f, 0.f, 0.f};
        cur = nxt; cA = nA; cB = nB; ++ui;
        if constexpr (ALIGN_EPI) { if (wr == 1) PG8_BAR; }
    }
    PG8_WAIT_V(0);
    if constexpr (!ALIGN_EPI) { if (wr == 0) PG8_BAR; }
    PG8_BAR;
    if constexpr (Epi::AFTER_DRAIN) { E.fused(acc, cur, wr, wc, fr, fq, lds, wid, lane); S.done(cur); }
#undef PG8_SA
#undef PG8_SB
#undef PG8_STAGE
#undef PG8_LDA
#undef PG8_LDB
#undef PG8_MMA
#undef PG8_WAIT_V
#undef PG8_WAIT_L
#undef PG8_BAR
#undef PG8_SCHED
}

constexpr size_t MiB = (size_t)1 << 20;
constexpr size_t OFF_RSTDX = 0, OFF_ROPE = 128 * 1024, OFF_AL = 384 * 1024, OFF_PTRS = 448 * 1024, OFF_BAR = 456 * 1024  , OFF_SSKV = 512 * 1024  , OFF_SSQ = 1024 * 1024  , OFF_SSY = 2048 * 1024  ;
constexpr size_t WS_W = 4 * MiB;
constexpr size_t WE_IN = 0, WE_UQ = 3407872, WE_UKV = 3702784, WE_OATT = 3964928, WE_GLU = 4489216, WE_OUT = 5537792, WE_UP = 6586368, WE_DOWN = 12353536, WE_TV = 15237120, WE_WST = 25722880;
constexpr size_t WS_SSX = 62 * MiB  , WS_SST4 = 61 * MiB + 512 * 1024  , WS_GRAN = 65 * MiB  , GRAN_BYTES = 4 * (size_t)32768 * 8;
constexpr size_t WS_XY = 68 * MiB;
constexpr size_t WS_GATES = 132 * MiB, WS_CQ = 260 * MiB, WS_CKV = 284 * MiB, WS_KPE = 300 * MiB, WS_UP = 302 * MiB, WS_Q = 342 * MiB, WS_KN = 390 * MiB, WS_V = 422 * MiB, WS_SST = 454 * MiB;
constexpr size_t WS_O = 260 * MiB, WS_MERGED = 342 * MiB, WS_YS5 = 422 * MiB;
constexpr size_t WS_G = 132 * MiB, WS_VAL = 308 * MiB;
constexpr size_t WS_YB = 132 * MiB;
constexpr size_t WS_GL = 484 * MiB, WS_GF = 488 * MiB, WS_VF = 492 * MiB;
constexpr size_t WS_END = 496 * MiB;

constexpr int LDS_BYTES = 131072 + 64 + 16384 + 64;
#ifndef PHMASK
#define PHMASK 0xFFF
#endif

#define EPI_ROWS_BEGIN _Pragma("unroll") for (int ai = 0; ai < 2; ++ai) _Pragma("unroll") for (int m = 0; m < 4; ++m) { const int row = u.pm * BM + ai * HALF + wr * 64 + m * 16 + fr;
#define EPI_ROWS_END }
__device__ __forceinline__ float sumsq8(const f32x4 a, const f32x4 b) { return (a[0] * a[0] + a[1] * a[1]) + (a[2] * a[2] + a[3] * a[3]) + (b[0] * b[0] + b[1] * b[1]) + (b[2] * b[2] + b[3] * b[3]); }
__device__ __forceinline__ void rope8(f32x4& v0, f32x4& v1, const float* rope, int pos, int fq) {
    const f32x4 cs0 = *(const f32x4*)(rope + (pos * 16 + 4 * fq) * 2), cs1 = *(const f32x4*)(rope + (pos * 16 + 4 * fq) * 2 + 4);
    const float c[4] = {cs0[0], cs0[2], cs1[0], cs1[2]}, s[4] = {cs0[1], cs0[3], cs1[1], cs1[3]};
    f32x4 o0, o1;
#pragma unroll
    for (int j = 0; j < 4; ++j) { o0[j] = v0[j] * c[j] - v1[j] * s[j]; o1[j] = v1[j] * c[j] + v0[j] * s[j]; }
    v0 = o0; v1 = o1;
}

__device__ __forceinline__ float row_rstd(const float* ssx, int row, float epsv, int lane, int fq) {
    const f32x4 a = *(const f32x4*)(ssx + (unsigned)row * 16 + 4 * fq); float t = (a[0] + a[1]) + (a[2] + a[3]); t += shx(t, 16, lane); t += shx(t, 32, lane);
    return rsqrtf(t * (1.0f / DM) + epsv);
}
struct EpiIn {
    static constexpr bool PERM = true, AFTER_DRAIN = false;
    const float* ssx; float epsv; bf16_t* CQ; bf16_t* KPE; bf16_t* CKV; bf16_t* UP; bf16_t* GATES; const float* bgate; float* ssq; float* sskv; const float* rope;
    __device__ __forceinline__ void operator()(const f32x4 (&acc)[2][2][4][2], const Unit& u, int wr, int wc, int fr, int fq) const {
        const int pn = u.pn;
        EPI_ROWS_BEGIN
            const float rs = row_rstd(ssx, row, epsv, fr | (fq << 4), fq);
            if (pn == 0) {
                float ss = 0.f;
#pragma unroll
                for (int bj = 0; bj < 2; ++bj) { const f32x4 v0 = acc[ai][bj][m][0] * rs, v1 = acc[ai][bj][m][1] * rs; ss += sumsq8(v0, v1);
                    *(u32x4*)(CQ + (unsigned)row * QL + bj * HALF + wc * 32 + fq * 8) = pack8(v0, v1); }
                ss += shx(ss, 16, fr | (fq << 4)); ss += shx(ss, 32, fr | (fq << 4));
                if (fq == 0) ssq[row * 8 + wc] = ss;
            } else if (pn == 1) {
                { const f32x4 v0 = acc[ai][0][m][0] * rs, v1 = acc[ai][0][m][1] * rs; float ss = sumsq8(v0, v1);
                  *(u32x4*)(CQ + (unsigned)row * QL + 256 + wc * 32 + fq * 8) = pack8(v0, v1);
                  ss += shx(ss, 16, fr | (fq << 4)); ss += shx(ss, 32, fr | (fq << 4));
                  if (fq == 0) ssq[row * 8 + 4 + wc] = ss; }
                if (wc == 0) { f32x4 v0 = acc[ai][1][m][0] * rs, v1 = acc[ai][1][m][1] * rs; rope8(v0, v1, rope, row & (SEQ - 1), fq);
                  *(u32x4*)(KPE + (unsigned)row * ROPE_D + fq * 8) = pack8(v0, v1); }
            } else if (pn == 2) {
                float ss = 0.f;
#pragma unroll
                for (int bj = 0; bj < 2; ++bj) { const f32x4 v0 = acc[ai][bj][m][0] * rs, v1 = acc[ai][bj][m][1] * rs; ss += sumsq8(v0, v1);
                    *(u32x4*)(CKV + (unsigned)row * KVL + bj * HALF + wc * 32 + fq * 8) = pack8(v0, v1); }
                ss += shx(ss, 16, fr | (fq << 4)); ss += shx(ss, 32, fr | (fq << 4));
                if (fq == 0) sskv[row * 4 + wc] = ss;
            } else if (pn < 5) {
#pragma unroll
                for (int bj = 0; bj < 2; ++bj) { const f32x4 v0 = acc[ai][bj][m][0] * rs, v1 = acc[ai][bj][m][1] * rs;
                    const int ucol = (pn - 3) * 256 + bj * HALF + wc * 32 + fq * 8; const int g = ucol >> 4, h0 = ucol & 15;
                    *(u32x4*)(UP + (unsigned)(g * NCHR + (row >> 5)) * KS5 + (row & 31) * 16 + h0) = pack8(v0, v1); }
            } else {
#pragma unroll
                for (int bj = 0; bj < 2; ++bj) { const int gcol = (pn - 5) * 256 + bj * HALF + wc * 32 + fq * 8;
                    const f32x4 b0 = *(const f32x4*)(bgate + gcol), b1 = *(const f32x4*)(bgate + gcol + 4);
                    f32x4 v0 = acc[ai][bj][m][0] * rs + b0, v1 = acc[ai][bj][m][1] * rs + b1;
#pragma unroll
                    for (int j = 0; j < 4; ++j) { v0[j] = sigmoid_f(v0[j]); v1[j] = sigmoid_f(v1[j]); }
                    *(u32x4*)(GATES + (unsigned)row * 2048 + gcol) = pack8(v0, v1); }
            }
        EPI_ROWS_END
    }
};

struct EpiQ {
    static constexpr bool PERM = true, AFTER_DRAIN = false;
    const float* ssq; bf16_t* Q; const float* rope; float c2, epsv;
    __device__ __forceinline__ void operator()(const f32x4 (&acc)[2][2][4][2], const Unit& u, int wr, int wc, int fr, int fq) const {
        EPI_ROWS_BEGIN
            const f32x4 sa = *(const f32x4*)(ssq + row * 8), sb = *(const f32x4*)(ssq + row * 8 + 4);
            const float rs = rsqrtf((((sa[0] + sa[1]) + (sa[2] + sa[3])) + ((sb[0] + sb[1]) + (sb[2] + sb[3]))) * (1.0f / QL) + epsv) * c2;
#pragma unroll
            for (int bj = 0; bj < 2; ++bj) { f32x4 v0 = acc[ai][bj][m][0] * rs, v1 = acc[ai][bj][m][1] * rs;
                const int gi = u.pn * 8 + bj * 4 + wc;
                if (gi % 3 == 2) rope8(v0, v1, rope, row & (SEQ - 1), fq);
                *(u32x4*)(Q + (unsigned)row * 768 + u.pn * 256 + bj * HALF + wc * 32 + fq * 8) = pack8(v0, v1); }
        EPI_ROWS_END
    }
};
struct EpiKV {
    static constexpr bool PERM = true, AFTER_DRAIN = false;
    const float* sskv; bf16_t* KN; bf16_t* V; float epsv;
    __device__ __forceinline__ void operator()(const f32x4 (&acc)[2][2][4][2], const Unit& u, int wr, int wc, int fr, int fq) const {
        bf16_t* base = u.pn < 2 ? KN + u.pn * 256 : V + (u.pn - 2) * 256;
        EPI_ROWS_BEGIN
            const f32x4 sa = *(const f32x4*)(sskv + row * 4);
            const float rs = rsqrtf(((sa[0] + sa[1]) + (sa[2] + sa[3])) * (1.0f / KVL) + epsv);
#pragma unroll
            for (int bj = 0; bj < 2; ++bj) { const f32x4 v0 = acc[ai][bj][m][0] * rs, v1 = acc[ai][bj][m][1] * rs;
                *(u32x4*)(base + (unsigned)row * 512 + bj * HALF + wc * 32 + fq * 8) = pack8(v0, v1); }
        EPI_ROWS_END
    }
};
struct EpiState {
    static constexpr bool PERM = true, AFTER_DRAIN = false;
    float* SST;
    __device__ __forceinline__ void operator()(const f32x4 (&acc)[2][2][4][2], const Unit& u, int wr, int wc, int fr, int fq) const {
        EPI_ROWS_BEGIN
            float* p = SST + (unsigned)(u.z * NCHR + row) * 128u + wc * 32 + fq * 8;
            *(f32x4*)p = acc[ai][0][m][0]; *(f32x4*)(p + 4) = acc[ai][0][m][1];
        EPI_ROWS_END
    }
};
struct EpiS5 {
    static constexpr bool PERM = true, AFTER_DRAIN = false;
    bf16_t* Y;
    __device__ __forceinline__ void operator()(const f32x4 (&acc)[2][2][4][2], const Unit& u, int wr, int wc, int fr, int fq) const {
        EPI_ROWS_BEGIN
#pragma unroll
            for (int bj = 0; bj < 2; ++bj) { f32x4 v0 = acc[ai][bj][m][0], v1 = acc[ai][bj][m][1];
#pragma unroll
                for (int j = 0; j < 4; ++j) { v0[j] = gelu_tanh(v0[j]); v1[j] = gelu_tanh(v1[j]); }
                const int c = u.pn * 256 + bj * HALF + wc * 32 + fq * 8; const int t = c >> 4, h0 = c & 15;
                *(u32x4*)(Y + ((unsigned)row * LCH + t) * SSMW + u.z * 16 + h0) = pack8(v0, v1); }
        EPI_ROWS_END
    }
};
struct EpiOatt {
    static constexpr bool PERM = true, AFTER_DRAIN = false;
    const bf16_t* GATES; bf16_t* MERGED;
    __device__ __forceinline__ void operator()(const f32x4 (&acc)[2][2][4][2], const Unit& u, int wr, int wc, int fr, int fq) const {
        EPI_ROWS_BEGIN
#pragma unroll
            for (int bj = 0; bj < 2; ++bj) { const int col = u.pn * 256 + bj * HALF + wc * 32 + fq * 8;
                const u32x4 gw = *(const u32x4*)(GATES + (unsigned)row * 2048 + col);
                f32x4 v0 = acc[ai][bj][m][0], v1 = acc[ai][bj][m][1];
                v0[0] *= bf_lo(gw.x); v0[1] *= bf_hi(gw.x); v0[2] *= bf_lo(gw.y); v0[3] *= bf_hi(gw.y);
                v1[0] *= bf_lo(gw.z); v1[1] *= bf_hi(gw.z); v1[2] *= bf_lo(gw.w); v1[3] *= bf_hi(gw.w);
                *(u32x4*)(MERGED + (unsigned)row * DM + col) = pack8(v0, v1); }
        EPI_ROWS_END
    }
};
struct EpiGlu {
    static constexpr bool PERM = true, AFTER_DRAIN = false;
    const bf16_t* GATES; bf16_t* MERGED;
    __device__ __forceinline__ void operator()(const f32x4 (&acc)[2][2][4][2], const Unit& u, int wr, int wc, int fr, int fq) const {
        EPI_ROWS_BEGIN
#pragma unroll
            for (int bj = 0; bj < 2; ++bj) { const int col = u.pn * 128 + bj * 64 + wc * 16 + fq * 4;
                const u32x2 gw = *(const u32x2*)(GATES + (unsigned)row * 2048 + 1024 + col);
                bf16_t* mp = MERGED + (unsigned)row * DM + col; const u32x2 mw = *(const u32x2*)mp;
                const f32x4 ga = acc[ai][bj][m][0], gb = acc[ai][bj][m][1];
                const float r0 = bf_lo(mw.x) + bf_lo(gw.x) * ga[0] * sigmoid_f(gb[0]), r1 = bf_hi(mw.x) + bf_hi(gw.x) * ga[1] * sigmoid_f(gb[1]);
                const float r2 = bf_lo(mw.y) + bf_lo(gw.y) * ga[2] * sigmoid_f(gb[2]), r3 = bf_hi(mw.y) + bf_hi(gw.y) * ga[3] * sigmoid_f(gb[3]);
                u32x2 o; o.x = cvt_pk_bf16(r0, r1); o.y = cvt_pk_bf16(r2, r3); *(u32x2*)mp = o; }
        EPI_ROWS_END
    }
};
struct EpiYN {
    static constexpr bool PERM = true, AFTER_DRAIN = false;
    bf16_t* XB; float* OUT; const float* gvec; unsigned long long* gran; float* ssx; unsigned epoch; float epsv; LAS float* red;
    __device__ __forceinline__ void operator()(const f32x4 (&acc)[2][2][4][2], const Unit& u, int wr, int wc, int fr, int fq) const {
        const int lane = fr | (fq << 4);
        const unsigned coff = u.pn * 256 + wc * 32 + fq * 8; const unsigned row0 = u.pm * BM + wr * 64 + fr;
        u32x4 xw[4][2];
#pragma unroll
        for (int m = 0; m < 4; ++m)
#pragma unroll
            for (int bj = 0; bj < 2; ++bj) xw[m][bj] = *(const u32x4*)(XB + (row0 + m * 16) * DM + coff + bj * HALF);
        f32x4 g0[2], g1[2];
#pragma unroll
        for (int bj = 0; bj < 2; ++bj) { const float* gp = gvec + coff + bj * HALF; g0[bj] = *(const f32x4*)gp; g1[bj] = *(const f32x4*)(gp + 4); }
        EPI_ROWS_BEGIN
            float ss = 0.f;
#pragma unroll
            for (int bj = 0; bj < 2; ++bj) ss += sumsq8(acc[ai][bj][m][0], acc[ai][bj][m][1]);
            ss += shx(ss, 16, lane); ss += shx(ss, 32, lane);
            if (fq == 0) red[(row - u.pm * BM) * 4 + wc] = ss;
        EPI_ROWS_END
        asm volatile("s_waitcnt lgkmcnt(0)" ::: "memory"); __builtin_amdgcn_s_barrier(); asm volatile("" ::: "memory");
        if (wr == 0 && wc == 0) {
#pragma unroll
            for (int j = 0; j < 4; ++j) { const f32x4 q = *(const LAS f32x4*)(red + (4 * lane + j) * 4); const float t = (q[0] + q[1]) + (q[2] + q[3]);
                __hip_atomic_store(gran + (size_t)u.pn * T_TOK + u.pm * BM + 4 * lane + j, ((unsigned long long)epoch << 32) | (unsigned long long)__float_as_uint(t), __ATOMIC_RELAXED, __HIP_MEMORY_SCOPE_AGENT); }
        }
        unsigned long long gv[2][4];
        { unsigned sp = 0;
          for (;;) { bool ok = true;
#pragma unroll
              for (int ai = 0; ai < 2; ++ai)
#pragma unroll
                  for (int m = 0; m < 4; ++m) { gv[ai][m] = __hip_atomic_load(gran + (size_t)fq * T_TOK + row0 + ai * HALF + m * 16, __ATOMIC_RELAXED, __HIP_MEMORY_SCOPE_AGENT); ok = ok && ((unsigned)(gv[ai][m] >> 32) == epoch); }
              if (__all(ok) || ++sp > (1u << 20)) break;
              __builtin_amdgcn_s_sleep(1); } }
#pragma unroll
        for (int ai = 0; ai < 2; ++ai) {
            if (ai == 1) {
#pragma unroll
                for (int m = 0; m < 4; ++m)
#pragma unroll
                    for (int bj = 0; bj < 2; ++bj) xw[m][bj] = *(const u32x4*)(XB + (row0 + HALF + m * 16) * DM + coff + bj * HALF);
            }
#pragma unroll
            for (int m = 0; m < 4; ++m) { const unsigned row = row0 + ai * HALF + m * 16;
                float tot = __uint_as_float((unsigned)gv[ai][m]); tot += shx(tot, 16, lane); tot += shx(tot, 32, lane);
                const float rs = rsqrtf(tot * (1.0f / DM) + epsv);
                float ss = 0.f;
#pragma unroll
                for (int bj = 0; bj < 2; ++bj) { const unsigned off = row * DM + coff + bj * HALF; const u32x4 x4 = xw[m][bj];
                    f32x4 v0 = acc[ai][bj][m][0] * rs * g0[bj], v1 = acc[ai][bj][m][1] * rs * g1[bj];
                    v0[0] += bf_lo(x4.x); v0[1] += bf_hi(x4.x); v0[2] += bf_lo(x4.y); v0[3] += bf_hi(x4.y); v1[0] += bf_lo(x4.z); v1[1] += bf_hi(x4.z); v1[2] += bf_lo(x4.w); v1[3] += bf_hi(x4.w);
                    ss += sumsq8(v0, v1);
                    if (OUT) { *(f32x4*)(OUT + off) = v0; *(f32x4*)(OUT + off + 4) = v1; } else *(u32x4*)(XB + off) = pack8(v0, v1); }
                ss += shx(ss, 16, lane); ss += shx(ss, 32, lane);
                if (fq == 0) ssx[row * 16 + u.pn * 4 + wc] = ss; }
            asm volatile("" ::: "memory");
        }
    }
};
__device__ __forceinline__ f32x4 dpp_shr(const f32x4 v, int  , const int ctrl_is_2) {
    f32x4 r;
#pragma unroll
    for (int j = 0; j < 4; ++j) { float x = v[j], d = 0.f;
        if (ctrl_is_2) asm volatile("s_nop 1\n\tv_mov_b32_dpp %0, %1 row_shr:2 row_mask:0xf bank_mask:0xf" : "+v"(d) : "v"(x));
        else           asm volatile("s_nop 1\n\tv_mov_b32_dpp %0, %1 row_shr:1 row_mask:0xf bank_mask:0xf" : "+v"(d) : "v"(x));
        r[j] = d; }
    return r;
}
struct EpiUpConv {
    static constexpr bool PERM = true, AFTER_DRAIN = false;
    const float* ssx; float epsv; const float* cw; const float* cb; bf16_t* ACT; float* GL; float* GF; float* VF; LAS float* X;
    __device__ __forceinline__ void operator()(const f32x4 (&acc)[2][2][4][2], const Unit& u, int wr, int wc, int fr, int fq) const {
        const int lane = fr | (fq << 4);
        const unsigned oc0 = u.pn * 128 + wc * 16 + fq * 4;
        float rsv[2][4];
#pragma unroll
        for (int ai = 0; ai < 2; ++ai)
#pragma unroll
            for (int m = 0; m < 4; ++m) rsv[ai][m] = row_rstd(ssx, u.pm * BM + ai * HALF + wr * 64 + m * 16 + fr, epsv, lane, fq);
        if (fr >= 14) {
#pragma unroll
            for (int ai = 0; ai < 2; ++ai)
#pragma unroll
                for (int m = 0; m < 4; ++m) { const int gidx = ai * 8 + wr * 4 + m;
#pragma unroll
                    for (int bj = 0; bj < 2; ++bj) { const f32x4 cur = acc[ai][bj][m][0] * rsv[ai][m];
                        *(LAS f32x4*)(X + ((((gidx * 4 + wc) * 2 + bj) * 2 + (fr - 14)) * 4 + fq) * 4) = cur;
                        if (gidx == 15) *(f32x4*)(GL + (size_t)(u.pm * 2 + (fr - 14)) * DFF + oc0 + bj * 64) = cur; } }
        }
        f32x4 w0[2], w1[2], w2[2], bb[2];
#pragma unroll
        for (int bj = 0; bj < 2; ++bj) { const unsigned oc = oc0 + bj * 64; w0[bj] = *(const f32x4*)(cw + oc); w1[bj] = *(const f32x4*)(cw + DFF + oc); w2[bj] = *(const f32x4*)(cw + 2 * DFF + oc); bb[bj] = *(const f32x4*)(cb + oc); }
        asm volatile("s_waitcnt lgkmcnt(0)" ::: "memory"); __builtin_amdgcn_s_barrier(); asm volatile("" ::: "memory");
#pragma unroll
        for (int ai = 0; ai < 2; ++ai)
#pragma unroll
            for (int m = 0; m < 4; ++m) { const int gidx = ai * 8 + wr * 4 + m; const unsigned row = u.pm * BM + ai * HALF + wr * 64 + m * 16 + fr; const float rs = rsv[ai][m];
#pragma unroll
                for (int bj = 0; bj < 2; ++bj) { const unsigned oc = oc0 + bj * 64;
                    const f32x4 cur = acc[ai][bj][m][0] * rs, val = acc[ai][bj][m][1] * rs;
                    f32x4 g1 = dpp_shr(cur, 0, 0), g2 = dpp_shr(cur, 0, 1);
                    if (fr < 2) {
                        f32x4 x14 = {0.f, 0.f, 0.f, 0.f}, x15 = x14;
                        if (gidx > 0) { const LAS float* xp = X + (((((gidx - 1) * 4 + wc) * 2 + bj) * 2) * 4 + fq) * 4; x14 = *(const LAS f32x4*)xp; x15 = *(const LAS f32x4*)(xp + 16); }
                        if (fr == 0) { g1 = x15; g2 = x14; } else g2 = x15;
                        if (gidx == 0) { *(f32x4*)(GF + (size_t)(u.pm * 2 + fr) * DFF + oc) = cur; *(f32x4*)(VF + (size_t)(u.pm * 2 + fr) * DFF + oc) = val; }
                    }
                    const f32x4 cv = bb[bj] + w0[bj] * g2 + w1[bj] * g1 + w2[bj] * cur;
                    f32x4 o;
#pragma unroll
                    for (int j = 0; j < 4; ++j) o[j] = gelu_tanh(cv[j]) * val[j];
                    u32x2 w; w.x = cvt_pk_bf16(o[0], o[1]); w.y = cvt_pk_bf16(o[2], o[3]);
                    *(u32x2*)(ACT + row * DFF + oc) = w; }
            }
    }
};

struct Args { const float* in[26]; float* out; unsigned char* ws; int ph_lo, ph_hi; };
struct Ctx { unsigned char* ws; const long long* dl; float* out;
    __device__ __forceinline__ const float* inp(int i) const { return (const float*)(ws + dl[i]); } };

enum { I_X = 0, I_WIN, I_BGATE, I_GMIXPRE, I_GQ, I_WUQ, I_GKV, I_WUKV, I_WOATT, I_LAMRE, I_LAMIM, I_LOGSTEP, I_BRE, I_BIM, I_CRE, I_CIM, I_DSKIP, I_WGLU, I_WOUT, I_GMIXPOST, I_GFFNPRE, I_WUP, I_CONVW, I_CONVB, I_WDOWN, I_GFFNPOST };

__device__ __forceinline__ float wave_sum(float v, int lane) {
#pragma unroll
    for (int o = 1; o < 64; o <<= 1) v += shx(v, o, lane);
    return v;
}

__device__ __forceinline__ int rope_sigma(int c) { return 4 * (c >> 3) + (c & 3) + 16 * ((c >> 2) & 1); }
__device__ __forceinline__ int src_col(int kind, int n) {
    if (kind == 0) {
        if (n < 384) return n;
        if (n < 416) return 640 + rope_sigma(n - 384);
        if (n < 512) return -1;
        if (n < 768) return 384 + (n - 512);
        if (n < 1280) return 672 + (n - 768);
        return 1184 + (n - 1280);
    } else if (kind == 1) {
        const int h = n / 96, c = n % 96; return c < 64 ? n : h * 96 + 64 + rope_sigma(c - 64);
    } else if (kind == 2) {
        const int hh = (n & 511) >> 6, d = n & 63; return hh * 128 + (n >= 512 ? 64 : 0) + d;
    } else if (kind == 3) {
        const int q = n >> 3, nn = (n >> 2) & 1, j = n & 3; return nn * 1024 + 4 * q + j;
    } else if (kind == 5) {
        const int q = n >> 3, nn = (n >> 2) & 1, j = n & 3; return nn * DFF + 4 * q + j;
    }
    return n;
}
__device__ __forceinline__ void transpose_item(int kind, const float* W, int K, int Nsrc, bf16_t* WT, const float* gk, LAS float* scr, int item, int nblk, int lane) {
    const int kb = item / nblk, nb = item % nblk, k0 = 64 * kb, n0 = 32 * nb;
    const int src = src_col(kind, n0 + (lane & 31));
    float v[32];
    const float* wp = W + (size_t)(k0 + (lane >> 5)) * Nsrc + (src >= 0 ? src : 0);
#pragma unroll
    for (int i = 0; i < 32; ++i) v[i] = wp[(size_t)(2 * i) * Nsrc];
    if (src < 0) {
#pragma unroll
        for (int i = 0; i < 32; ++i) v[i] = 0.f;
    }
    if (gk) {
#pragma unroll
        for (int i = 0; i < 32; ++i) v[i] *= gk[k0 + 2 * i + (lane >> 5)];
    }
#pragma unroll
    for (int i = 0; i < 32; ++i) scr[(2 * i + (lane >> 5)) * 33 + (lane & 31)] = v[i];
    asm volatile("s_waitcnt lgkmcnt(0)" ::: "memory");
    const int c = lane & 7;
#pragma unroll
    for (int j = 0; j < 4; ++j) { const int n = (lane >> 3) + 8 * j; const LAS float* s = scr + (8 * c) * 33 + n;
        u32x4 o; o.x = cvt_pk_bf16(s[0 * 33], s[1 * 33]); o.y = cvt_pk_bf16(s[2 * 33], s[3 * 33]); o.z = cvt_pk_bf16(s[4 * 33], s[5 * 33]); o.w = cvt_pk_bf16(s[6 * 33], s[7 * 33]);
        *(u32x4*)(WT + (size_t)(n0 + n) * K + k0 + 8 * c) = o; }
    asm volatile("s_waitcnt lgkmcnt(0)" ::: "memory");
}

__device__ __forceinline__ void sincos_red(float x, float& sn, float& cs) {
    const float k = rintf(x * 0.15915494309189535f);
    float r = fmaf(-k, 6.28125f, x); r = fmaf(-k, 1.9353071795864769e-3f, r);
    sn = __sinf(r); cs = __cosf(r);
}
__device__ __forceinline__ void s5_prep_item(const Ctx& a, int l, int g, int qt, LAS unsigned char* lds, int tid) {
    constexpr int PS = 65;
    LAS float* pr = (LAS float*)lds; LAS float* pi = pr + 2176; LAS float* bbr = pi + 2176; LAS float* bbi = bbr + 1024;
    LAS float* crT = bbi + 1024; LAS float* ciT = crT + 1024; LAS float* Kt = ciT + 1024; LAS float* frv = Kt + 8192; LAS float* fiv = frv + 64;
    const int lg = l * NGRP + g;
    const float delta = __expf(a.inp(I_LOGSTEP)[lg]);
    for (int idx = tid; idx < 33 * 64; idx += 512) { const int tau = idx >> 6, p = idx & 63;
        const float lr = a.inp(I_LAMRE)[lg * 64 + p], li = a.inp(I_LAMIM)[lg * 64 + p];
        const float mag = __expf(lr * delta * (float)tau);
        float sn, cs; sincos_red(li * delta * (float)tau, sn, cs);
        pr[tau * PS + p] = mag * cs; pi[tau * PS + p] = mag * sn; }
    for (int idx = tid; idx < 1024; idx += 512) { const int h = idx >> 6, p = idx & 63; crT[p * 16 + h] = a.inp(I_CRE)[(size_t)lg * 1024 + idx]; ciT[p * 16 + h] = a.inp(I_CIM)[(size_t)lg * 1024 + idx]; }
    if (tid < 64) { const int p = tid;
        const float lr = a.inp(I_LAMRE)[lg * 64 + p], li = a.inp(I_LAMIM)[lg * 64 + p];
        const float xe = lr * delta; const float em = xe * (1.0f + xe * (0.5f + xe * (0.16666667f + xe * (0.041666668f + xe * 0.0083333338f))));
        float sn, cs, sh, ch; sincos_red(li * delta, sn, cs); sincos_red(0.5f * li * delta, sh, ch);
        const float nr = em * cs - 2.0f * sh * sh, ni = (1.0f + em) * sn, den = lr * lr + li * li;
        frv[p] = (nr * lr + ni * li) / den; fiv[p] = (ni * lr - nr * li) / den; }
    __syncthreads();
    if (qt == 0 && tid < 64) { float* AL = (float*)(a.ws + OFF_AL); AL[(g * 64 + tid) * 2] = pr[32 * PS + tid]; AL[(g * 64 + tid) * 2 + 1] = pi[32 * PS + tid]; }
    for (int idx = tid; idx < 1024; idx += 512) { const int p = idx >> 4;
        const float br = a.inp(I_BRE)[(size_t)lg * 1024 + idx], bi = a.inp(I_BIM)[(size_t)lg * 1024 + idx];
        bbr[idx] = frv[p] * br - fiv[p] * bi; bbi[idx] = frv[p] * bi + fiv[p] * br; }
    __syncthreads();
    {
        const int tau = tid >> 4, h = tid & 15;
        f32x4 s0 = {0.f, 0.f, 0.f, 0.f}, s1 = s0, s2 = s0, s3 = s0;
        for (int p = 0; p < 64; ++p) { const float c_r = crT[p * 16 + h], c_i = ciT[p * 16 + h], a_r = pr[tau * PS + p], a_i = pi[tau * PS + p];
            const float car = c_r * a_r - c_i * a_i, cai = c_r * a_i + c_i * a_r;
            const LAS f32x4* br4 = (const LAS f32x4*)(bbr + p * 16); const LAS f32x4* bi4 = (const LAS f32x4*)(bbi + p * 16);
            s0 += car * br4[0] - cai * bi4[0]; s1 += car * br4[1] - cai * bi4[1]; s2 += car * br4[2] - cai * bi4[2]; s3 += car * br4[3] - cai * bi4[3]; }
        if (tau == 0) { const float dd = a.inp(I_DSKIP)[l * SSMW + g * 16 + h];
            if ((h >> 2) == 0) s0[h & 3] += dd; else if ((h >> 2) == 1) s1[h & 3] += dd; else if ((h >> 2) == 2) s2[h & 3] += dd; else s3[h & 3] += dd; }
        LAS f32x4* kp = (LAS f32x4*)(Kt + tau * 256 + h * 16); kp[0] = s0; kp[1] = s1; kp[2] = s2; kp[3] = s3;
    }
    __syncthreads();
    bf16_t* TVg = (bf16_t*)(a.ws + WS_W) + WE_TV + (size_t)g * 512 * KS5;
    for (int it = tid; it < 128 * 80; it += 512) { const int n = 128 * qt + it / 80, kc = it % 80, t = n >> 4, h = n & 15; float v[8];
        if (kc < 64) { const int s = kc >> 1, hp0 = (kc & 1) * 8;
#pragma unroll
            for (int j = 0; j < 8; ++j) v[j] = (s <= t) ? Kt[((t - s) & 31) * 256 + h * 16 + hp0 + j] : 0.f;
        } else if (kc < 72) { const int p0 = (kc - 64) * 8;
#pragma unroll
            for (int j = 0; j < 8; ++j) { const int p = p0 + j; v[j] = crT[p * 16 + h] * pr[(t + 1) * PS + p] - ciT[p * 16 + h] * pi[(t + 1) * PS + p]; }
        } else { const int p0 = (kc - 72) * 8;
#pragma unroll
            for (int j = 0; j < 8; ++j) { const int p = p0 + j; v[j] = -(crT[p * 16 + h] * pi[(t + 1) * PS + p] + ciT[p * 16 + h] * pr[(t + 1) * PS + p]); }
        }
        u32x4 o; o.x = cvt_pk_bf16(v[0], v[1]); o.y = cvt_pk_bf16(v[2], v[3]); o.z = cvt_pk_bf16(v[4], v[5]); o.w = cvt_pk_bf16(v[6], v[7]);
        *(u32x4*)(TVg + (size_t)n * KS5 + kc * 8) = o; }
    bf16_t* Wg = (bf16_t*)(a.ws + WS_W) + WE_WST + (size_t)g * 256 * 512;
    for (int it = tid; it < 64 * 64; it += 512) { const int n = 64 * qt + (it >> 6), kc = it & 63, s = kc >> 1, hp0 = (kc & 1) * 8, tau = 31 - s; float v[8];
        if (n < 64) { const int p = n;
#pragma unroll
            for (int j = 0; j < 8; ++j) v[j] = pr[tau * PS + p] * bbr[p * 16 + hp0 + j] - pi[tau * PS + p] * bbi[p * 16 + hp0 + j];
        } else if (n < 128) { const int p = n - 64;
#pragma unroll
            for (int j = 0; j < 8; ++j) v[j] = pr[tau * PS + p] * bbi[p * 16 + hp0 + j] + pi[tau * PS + p] * bbr[p * 16 + hp0 + j];
        } else {
#pragma unroll
            for (int j = 0; j < 8; ++j) v[j] = 0.f;
        }
        u32x4 o; o.x = cvt_pk_bf16(v[0], v[1]); o.y = cvt_pk_bf16(v[2], v[3]); o.z = cvt_pk_bf16(v[4], v[5]); o.w = cvt_pk_bf16(v[6], v[7]);
        *(u32x4*)(Wg + (size_t)n * 512 + kc * 8) = o; }
    __syncthreads();
}

__device__ __forceinline__ void prep_layer(const Ctx& a, int l, LAS unsigned char* lds, int tid, int wid, int lane, int G, int cu, int part) {
    if (part == 0) for (int it = cu; it < NGRP * 4; it += G) s5_prep_item(a, l, it >> 2, it & 3, lds, tid);
    __syncthreads();
    LAS float* scr = (LAS float*)(lds + wid * 16384);
    bf16_t* Wb = (bf16_t*)(a.ws + WS_W);
    constexpr int N_IN = 16 * 104, N_UQ = 6 * 24, N_UKV = 4 * 32, N_OATT = 8 * 32, N_GLU = 8 * 64, N_OUT = 16 * 32, N_UP = 16 * 176, N_DOWN = 44 * 32;
    constexpr int NITEMS = N_IN + N_UQ + N_UKV + N_OATT + N_GLU + N_OUT + N_UP + N_DOWN;
    constexpr int N_MIX = N_IN + N_UQ + N_UKV + N_OATT + N_GLU + N_OUT;
    const int gw = part == 0 ? ((cu + G / 2) % G) * 8 + wid : N_MIX + (cu - G / 2) * 8 + wid;
    const int NGW = part == 0 ? G * 8 : (G - G / 2) * 8, iend = part == 0 ? N_MIX : NITEMS;
    for (int it = gw; it < iend; it += NGW) { int r = it, kind, si, gi, K, Nsrc, nblk; size_t lstride, doff;
        if (r < N_IN) { kind = 0; si = I_WIN; gi = I_GMIXPRE; K = DM; Nsrc = INC; nblk = 104; lstride = (size_t)DM * INC; doff = WE_IN; }
        else if ((r -= N_IN) < N_UQ) { kind = 1; si = I_WUQ; gi = I_GQ; K = QL; Nsrc = 768; nblk = 24; lstride = (size_t)QL * 768; doff = WE_UQ; }
        else if ((r -= N_UQ) < N_UKV) { kind = 2; si = I_WUKV; gi = I_GKV; K = KVL; Nsrc = 1024; nblk = 32; lstride = (size_t)KVL * 1024; doff = WE_UKV; }
        else if ((r -= N_UKV) < N_OATT) { kind = 4; si = I_WOATT; gi = -1; K = 512; Nsrc = DM; nblk = 32; lstride = (size_t)512 * DM; doff = WE_OATT; }
        else if ((r -= N_OATT) < N_GLU) { kind = 3; si = I_WGLU; gi = -1; K = SSMW; Nsrc = 2048; nblk = 64; lstride = (size_t)SSMW * 2048; doff = WE_GLU; }
        else if ((r -= N_GLU) < N_OUT) { kind = 4; si = I_WOUT; gi = -1; K = DM; Nsrc = DM; nblk = 32; lstride = (size_t)DM * DM; doff = WE_OUT; }
        else if ((r -= N_OUT) < N_UP) { kind = 5; si = I_WUP; gi = I_GFFNPRE; K = DM; Nsrc = 2 * DFF; nblk = 176; lstride = (size_t)DM * 2 * DFF; doff = WE_UP; }
        else { r -= N_UP; kind = 4; si = I_WDOWN; gi = -1; K = DFF; Nsrc = DM; nblk = 32; lstride = (size_t)DFF * DM; doff = WE_DOWN; }
        const float* W = a.inp(si) + (size_t)l * lstride; const float* gk = gi >= 0 ? a.inp(gi) + (size_t)l * K : nullptr;
        transpose_item(kind, W, K, Nsrc, Wb + doff, gk, scr, r, nblk, lane);
    }
    __syncthreads();
}

__device__ __forceinline__ void init_phase(const Ctx& a, int tid, int wid, int lane, int G, int cu, float epsv) {
    const int gw = cu * 8 + wid, NGW = G * 8;
    bf16_t* XB = (bf16_t*)(a.ws + WS_XY); float* ssx = (float*)(a.ws + WS_SSX);
    for (int row = gw; row < T_TOK; row += NGW) {
        const f32x4* xr = (const f32x4*)(a.inp(I_X) + (size_t)row * DM) + lane; u32x2* bo = (u32x2*)(XB + (size_t)row * DM) + lane;
        float ss = 0.f;
#pragma unroll
        for (int j = 0; j < 4; ++j) { const f32x4 v = xr[64 * j]; ss += (v[0] * v[0] + v[1] * v[1]) + (v[2] * v[2] + v[3] * v[3]);
            u32x2 w; w.x = cvt_pk_bf16(v[0], v[1]); w.y = cvt_pk_bf16(v[2], v[3]); bo[64 * j] = w; }
        ss = wave_sum(ss, lane);
        if (lane < 16) ssx[row * 16 + lane] = lane == 0 ? ss : 0.f;
    }
    const int gt = cu * 512 + tid, NT = G * 512;
    float* rope = (float*)(a.ws + OFF_ROPE);
    for (int i = gt; i < SEQ * 16; i += NT) { const int pos = i >> 4, k = i & 15;
        const float inv = exp2f(-(float)k * 0.83048202372184058696f);
        float sn, cs; sincos_red((float)pos * inv, sn, cs);
        rope[2 * i] = cs; rope[2 * i + 1] = sn; }
}

__device__ __forceinline__ void normres_phase(const Ctx& a, const float* gvec, const float* ssy, int tid, int wid, int lane, int G, int cu, float epsv, bool final_out) {
    const int gw = cu * 8 + wid, NGW = G * 8;
    float* X = a.out; bf16_t* XB = (bf16_t*)(a.ws + WS_XY); const bf16_t* YB = (const bf16_t*)(a.ws + WS_YB); float* rstdx = (float*)(a.ws + OFF_RSTDX);
    f32x4 gv[4];
#pragma unroll
    for (int j = 0; j < 4; ++j) gv[j] = ((const f32x4*)gvec)[lane + 64 * j];
    for (int row0 = gw * 4; row0 < T_TOK; row0 += NGW * 4) {
        u32x2 xw[4][4], yw[4][4]; float rs[4];
#pragma unroll
        for (int r = 0; r < 4; ++r) { const int row = row0 + r;
            const u32x2* xp = (const u32x2*)(XB + (size_t)row * DM) + lane; const u32x2* yp = (const u32x2*)(YB + (size_t)row * DM) + lane;
#pragma unroll
            for (int j = 0; j < 4; ++j) { xw[r][j] = xp[64 * j]; yw[r][j] = yp[64 * j]; }
            rs[r] = ssy[row * 16 + (lane & 15)]; }
#pragma unroll
        for (int r = 0; r < 4; ++r) { const int row = row0 + r;
            float sp_ = rs[r];
            sp_ += shx(sp_, 1, lane); sp_ += shx(sp_, 2, lane); sp_ += shx(sp_, 4, lane); sp_ += shx(sp_, 8, lane);
            const float rsv = rsqrtf(sp_ * (1.0f / DM) + epsv);
            u32x2* xp = (u32x2*)(XB + (size_t)row * DM) + lane; f32x4* op = (f32x4*)(X + (size_t)row * DM) + lane;
            float ss = 0.f;
#pragma unroll
            for (int j = 0; j < 4; ++j) { const u32x2 x2 = xw[r][j], y2 = yw[r][j]; f32x4 v;
                v[0] = bf_lo(x2.x) + bf_lo(y2.x) * rsv * gv[j][0]; v[1] = bf_hi(x2.x) + bf_hi(y2.x) * rsv * gv[j][1]; v[2] = bf_lo(x2.y) + bf_lo(y2.y) * rsv * gv[j][2]; v[3] = bf_hi(x2.y) + bf_hi(y2.y) * rsv * gv[j][3];
                ss += (v[0] * v[0] + v[1] * v[1]) + (v[2] * v[2] + v[3] * v[3]);
                if (final_out) op[64 * j] = v;
                else { u32x2 w; w.x = cvt_pk_bf16(v[0], v[1]); w.y = cvt_pk_bf16(v[2], v[3]); xp[64 * j] = w; } }
            ss = wave_sum(ss, lane);
            if (lane == 0) rstdx[row] = rsqrtf(ss * (1.0f / DM) + epsv);
        }
    }
}

__device__ __forceinline__ void conv_fixup_phase(const Ctx& a, int l, int tid, int G, int cu) {
    const int gt = cu * 512 + tid, NT = G * 512;
    const float* GL = (const float*)(a.ws + WS_GL); const float* GF = (const float*)(a.ws + WS_GF); const float* VF = (const float*)(a.ws + WS_VF); bf16_t* ACT = (bf16_t*)(a.ws + WS_VAL);
    const float* cw = a.inp(I_CONVW) + (size_t)l * 3 * DFF; const float* cb = a.inp(I_CONVB) + (size_t)l * DFF;
    constexpr int NC4 = DFF / 4;
    for (int it = gt; it < (T_TOK / BM) * NC4; it += NT) { const int pm = it / NC4, oc = (it - pm * NC4) * 4;
        const f32x4 z = {0.f, 0.f, 0.f, 0.f};
        const bool first = (pm & (SEQ / BM - 1)) == 0;
        const f32x4 p14 = first ? z : *(const f32x4*)(GL + (size_t)((pm - 1) * 2 + 0) * DFF + oc), p15 = first ? z : *(const f32x4*)(GL + (size_t)((pm - 1) * 2 + 1) * DFF + oc);
        const f32x4 c0 = *(const f32x4*)(GF + (size_t)(pm * 2 + 0) * DFF + oc), c1 = *(const f32x4*)(GF + (size_t)(pm * 2 + 1) * DFF + oc);
        const f32x4 v0 = *(const f32x4*)(VF + (size_t)(pm * 2 + 0) * DFF + oc), v1 = *(const f32x4*)(VF + (size_t)(pm * 2 + 1) * DFF + oc);
        const f32x4 w0 = *(const f32x4*)(cw + oc), w1 = *(const f32x4*)(cw + DFF + oc), w2 = *(const f32x4*)(cw + 2 * DFF + oc), bb = *(const f32x4*)(cb + oc);
        const f32x4 cv0 = bb + w0 * p14 + w1 * p15 + w2 * c0, cv1 = bb + w0 * p15 + w1 * c0 + w2 * c1;
        f32x4 o0, o1;
#pragma unroll
        for (int j = 0; j < 4; ++j) { o0[j] = gelu_tanh(cv0[j]) * v0[j]; o1[j] = gelu_tanh(cv1[j]) * v1[j]; }
        u32x2 w; w.x = cvt_pk_bf16(o0[0], o0[1]); w.y = cvt_pk_bf16(o0[2], o0[3]); *(u32x2*)(ACT + (size_t)(pm * BM) * DFF + oc) = w;
        w.x = cvt_pk_bf16(o1[0], o1[1]); w.y = cvt_pk_bf16(o1[2], o1[3]); *(u32x2*)(ACT + (size_t)(pm * BM + 1) * DFF + oc) = w;
    }
}

__device__ __forceinline__ void carry_phase(const Ctx& a, int tid, int G, int cu) {
    const float* AL = (const float*)(a.ws + OFF_AL); const float* SST = (const float*)(a.ws + WS_SST); bf16_t* UP = (bf16_t*)(a.ws + WS_UP);
    if (tid < 128)
    for (int idx = cu * 128 + tid; idx < NBATCH * NGRP * NST; idx += G * 128) { const int p = idx & 63, g = (idx >> 6) & 31, b = idx >> 11;
        const float alr = AL[(g * 64 + p) * 2], ali = AL[(g * 64 + p) * 2 + 1]; float sr = 0.f, si = 0.f;
        const size_t R0 = (size_t)g * NCHR + b * (SEQ / LCH);
#pragma unroll
        for (int h = 0; h < 2; ++h) {
            float xr[32], xi[32];
#pragma unroll
            for (int c = 0; c < 32; ++c) { xr[c] = SST[(R0 + h * 32 + c) * 128 + p]; xi[c] = SST[(R0 + h * 32 + c) * 128 + 64 + p]; }
#pragma unroll
            for (int c = 0; c < 32; ++c) { const size_t R = R0 + h * 32 + c;
                UP[R * KS5 + 512 + p] = (bf16_t)(cvt_pk_bf16(sr, 0.f) & 0xffffu); UP[R * KS5 + 576 + p] = (bf16_t)(cvt_pk_bf16(si, 0.f) & 0xffffu);
                const float nr = alr * sr - ali * si + xr[c], ni = alr * si + ali * sr + xi[c]; sr = nr; si = ni; }
        }
    }
}

typedef __attribute__((address_space(3))) const char* lds_cptr;
typedef short v4i16_t __attribute__((ext_vector_type(4)));
__device__ __forceinline__ s16x4 vtr(lds_cptr p) { return __builtin_bit_cast(s16x4, __builtin_amdgcn_ds_read_tr16_b64_v4i16((__attribute__((address_space(3))) v4i16_t*)p)); }

__device__ __forceinline__ float quad_max(float x) {
    float p = x, q = x; asm volatile("s_nop 1\n\tv_permlane32_swap_b32 %0, %1" : "+v"(p), "+v"(q));
    float m = fmaxf(p, q); p = m; q = m; asm volatile("s_nop 1\n\tv_permlane16_swap_b32 %0, %1" : "+v"(p), "+v"(q));
    return fmaxf(p, q);
}
__device__ __forceinline__ float quad_sum(float x) {
    float p = x, q = x; asm volatile("s_nop 1\n\tv_permlane32_swap_b32 %0, %1" : "+v"(p), "+v"(q));
    float m = p + q; p = m; q = m; asm volatile("s_nop 1\n\tv_permlane16_swap_b32 %0, %1" : "+v"(p), "+v"(q));
    return p + q;
}
__device__ __forceinline__ void attn_tile(LAS unsigned char* Kb, LAS unsigned char* Vb, const bf16x8 (&qf)[2][3], f32x4 (&o)[4][2], float (&mrun)[2], float (&lrun)[2], int l15, int quad, int lane) {
            f32x4 s[4][2];
            bf16x8 kf[4][3];
#pragma unroll
            for (int kb = 0; kb < 4; ++kb)
#pragma unroll
                for (int dc = 0; dc < 3; ++dc) kf[kb][dc] = *(const LAS bf16x8*)(Kb + (kb * 16 + l15) * 256 + (((dc * 4 + quad) ^ l15) << 4));
            __builtin_amdgcn_sched_barrier(0);
#pragma unroll
            for (int kb = 0; kb < 4; ++kb) {
#pragma unroll
                for (int dc = 0; dc < 3; ++dc) {
#pragma unroll
                    for (int qk = 0; qk < 2; ++qk) s[kb][qk] = __builtin_amdgcn_mfma_f32_16x16x32_bf16(kf[kb][dc], qf[qk][dc], dc == 0 ? (f32x4){0.f, 0.f, 0.f, 0.f} : s[kb][qk], 0, 0, 0); }
            }
            s16x4 vlo[2][4], vhi[2][4];
#pragma unroll
            for (int kk = 0; kk < 2; ++kk)
#pragma unroll
                for (int d = 0; d < 4; ++d) { const lds_cptr vp = (lds_cptr)(Vb + (32 * kk + 4 * quad + (l15 >> 2)) * 160 + (16 * d + 4 * (lane & 3)) * 2); vlo[kk][d] = vtr(vp); vhi[kk][d] = vtr(vp + 16 * 160); }
            __builtin_amdgcn_sched_barrier(0);
            float mx2[2];
#pragma unroll
            for (int qk = 0; qk < 2; ++qk) {
                float mx = s[0][qk][0];
#pragma unroll
                for (int kb = 0; kb < 4; ++kb)
#pragma unroll
                    for (int j = 0; j < 4; ++j) mx = fmaxf(mx, s[kb][qk][j]);
                mx2[qk] = quad_max(mx); }
            if (!__all((mx2[0] - mrun[0] <= 8.0f) && (mx2[1] - mrun[1] <= 8.0f))) {
#pragma unroll
                for (int qk = 0; qk < 2; ++qk) { const float mn = fmaxf(mrun[qk], mx2[qk]), alpha = __builtin_amdgcn_exp2f(mrun[qk] - mn); mrun[qk] = mn; lrun[qk] *= alpha;
#pragma unroll
                    for (int d = 0; d < 4; ++d) o[d][qk] = o[d][qk] * alpha; }
            }
#pragma unroll
            for (int qk = 0; qk < 2; ++qk) { const float mn = mrun[qk]; float rsum = 0.f;
#pragma unroll
                for (int kb = 0; kb < 4; ++kb)
#pragma unroll
                    for (int j = 0; j < 4; ++j) { const float p = __builtin_amdgcn_exp2f(s[kb][qk][j] - mn); rsum += p; s[kb][qk][j] = p; }
                lrun[qk] += rsum; }
#pragma unroll
            for (int kk = 0; kk < 2; ++kk) {
                bf16x8 pf[2];
#pragma unroll
                for (int qk = 0; qk < 2; ++qk) { const u32x4 w = pack8(s[2 * kk][qk], s[2 * kk + 1][qk]); pf[qk] = __builtin_bit_cast(bf16x8, w); }
#pragma unroll
                for (int d = 0; d < 4; ++d) {
                    const s16x4 lo = vlo[kk][d], hi = vhi[kk][d];
                    const bf16x8 vf = (bf16x8){lo[0], lo[1], lo[2], lo[3], hi[0], hi[1], hi[2], hi[3]};
#pragma unroll
                    for (int qk = 0; qk < 2; ++qk) o[d][qk] = __builtin_amdgcn_mfma_f32_16x16x32_bf16(vf, pf[qk], o[d][qk], 0, 0, 0);
                }
            }
}
__device__ __forceinline__ void attn_unit(const Ctx& a, LAS unsigned char* lds, int b, int h, int qb, int tid, int wid, int lane) {
    const bf16_t* Q = (const bf16_t*)(a.ws + WS_Q); const bf16_t* KN = (const bf16_t*)(a.ws + WS_KN); const bf16_t* KPE = (const bf16_t*)(a.ws + WS_KPE);
    const bf16_t* V = (const bf16_t*)(a.ws + WS_V); bf16_t* O = (bf16_t*)(a.ws + WS_O);
    const int l15 = lane & 15, quad = lane >> 4;
    const int ntile = 4 * qb + 4, cw = 4 * qb + (wid >> 1);
    const size_t tok0 = (size_t)b * SEQ;
    bf16x8 qf[2][3];
#pragma unroll
    for (int qk = 0; qk < 2; ++qk)
#pragma unroll
        for (int dc = 0; dc < 3; ++dc) qf[qk][dc] = *(const bf16x8*)(Q + (tok0 + qb * 256 + wid * 32 + qk * 16 + l15) * 768 + h * QKD + dc * 32 + quad * 8);
    f32x4 o[4][2];
#pragma unroll
    for (int d = 0; d < 4; ++d) { o[d][0] = (f32x4){0.f, 0.f, 0.f, 0.f}; o[d][1] = (f32x4){0.f, 0.f, 0.f, 0.f}; }
    float mrun[2] = {-INFINITY, -INFINITY}, lrun[2] = {0.f, 0.f};
    const int kkey = tid >> 3, kch = tid & 7;
    const int pkey = (tid >> 2) & 63, pch = 8 + (tid & 3);
    const unsigned k_lds = kkey * 256 + ((kch ^ (kkey & 15)) << 4), p_lds = pkey * 256 + ((pch ^ (pkey & 15)) << 4), v_lds = kkey * 160 + kch * 16;
    const bf16_t* gk = KN + (tok0 + kkey) * 512 + h * 64 + kch * 8; const bf16_t* gp = KPE + (tok0 + pkey) * ROPE_D + (tid & 3) * 8; const bf16_t* gv = V + (tok0 + kkey) * 512 + h * 64 + kch * 8;
    u32x4 r0k = *(const u32x4*)gk, r0v = *(const u32x4*)gv, r0p = (u32x4){0u, 0u, 0u, 0u};
    r0p = *(const u32x4*)gp;
    u32x4 r1k = *(const u32x4*)(gk + (size_t)64 * 512), r1v = *(const u32x4*)(gv + (size_t)64 * 512), r1p = (u32x4){0u, 0u, 0u, 0u};
    r1p = *(const u32x4*)(gp + (size_t)64 * ROPE_D);
    *(LAS u32x4*)(lds + k_lds) = r0k; *(LAS u32x4*)(lds + 32768 + v_lds) = r0v; *(LAS u32x4*)(lds + p_lds) = r0p;
    __syncthreads();
#define ATT_STEP(KT, RAk, RAv, RAp, RBk, RBv, RBp) { const int kt_ = (KT); \
        { const int ktl = (kt_ + 2 < ntile) ? kt_ + 2 : ntile - 1; const size_t adv = (size_t)ktl * 64;     \
          RAk = *(const u32x4*)(gk + adv * 512); RAv = *(const u32x4*)(gv + adv * 512); RAp = *(const u32x4*)(gp + adv * ROPE_D); } \
        if (kt_ <= cw) attn_tile(lds + (kt_ & 1) * 16384, lds + 32768 + (kt_ & 1) * 10240, qf, o, mrun, lrun, l15, quad, lane); \
        { const int nb = (kt_ + 1) & 1; \
            *(LAS u32x4*)(lds + nb * 16384 + k_lds) = RBk; *(LAS u32x4*)(lds + 32768 + nb * 10240 + v_lds) = RBv; *(LAS u32x4*)(lds + nb * 16384 + p_lds) = RBp; } \
        __syncthreads(); }
    for (int kt = 0; kt < ntile; kt += 2) {
        ATT_STEP(kt, r0k, r0v, r0p, r1k, r1v, r1p)
        ATT_STEP(kt + 1, r1k, r1v, r1p, r0k, r0v, r0p)
    }
#undef ATT_STEP
#pragma unroll
    for (int qk = 0; qk < 2; ++qk) { const float lt = quad_sum(lrun[qk]); const float inv = 1.0f / lt;
        bf16_t* op = O + (tok0 + qb * 256 + wid * 32 + qk * 16 + l15) * 512 + h * 64 + 4 * quad;
#pragma unroll
        for (int d = 0; d < 4; ++d) { const f32x4 v = o[d][qk] * inv; u32x2 w; w.x = cvt_pk_bf16(v[0], v[1]); w.y = cvt_pk_bf16(v[2], v[3]); *(u32x2*)(op + 16 * d) = w; }
    }
}
__device__ __forceinline__ void attn_phase(const Ctx& a, LAS unsigned char* lds, int tid, int wid, int lane, int G, int c) {
    for (int i = 0;; ++i) { const int L = i * G + ((i & 1) ? (G - 1 - c) : c); if (L >= NBATCH * NHEAD * 8) break;
        const int qb = 7 - (L >> 7), bh = L & 127;
        attn_unit(a, lds, bh >> 3, bh & 7, qb, tid, wid, lane); }
}

#define XB_TMO      128
#define XB_XCNT(j)  (256  + 64 * (j))
#define XB_XSUB(j)  (1280 + 64 * (j))
#define XB_XGEN(j)  (2304 + 64 * (j))
#define XB_TOP      3328
#define XB_TOPGEN   3392
#define XCD_BAR_WORDS 3456
#define XB_SPIN_CAP (1u << 18)

__device__ __forceinline__ unsigned xb_ld(unsigned* p)              { return __hip_atomic_load(p, __ATOMIC_RELAXED, __HIP_MEMORY_SCOPE_AGENT); }
__device__ __forceinline__ unsigned xb_add(unsigned* p, unsigned v) { return __hip_atomic_fetch_add(p, v, __ATOMIC_RELAXED, __HIP_MEMORY_SCOPE_AGENT); }
__device__ __forceinline__ unsigned xb_xcc_id() { return (unsigned)__builtin_amdgcn_s_getreg((3 << 11) | 20) & 0xFu; }
#define XB_SPIN(cond, bar) do { unsigned _sp = 0; while (cond) { __builtin_amdgcn_s_sleep(1); \
    if ((++_sp & 255u) == 0u) { if (xb_ld(&(bar)[XB_TMO])) break; if (_sp > XB_SPIN_CAP) { atomicAdd(&(bar)[XB_TMO], 1u); break; } } } } while (0)

struct XcdBarrier {
    unsigned* bar; unsigned x;
    volatile LAS unsigned* st;
};

__device__ __forceinline__ XcdBarrier xcd_barrier_post(unsigned* bar, volatile LAS unsigned* st) {
    XcdBarrier b; b.bar = bar; b.x = xb_xcc_id(); b.st = st;
    if (threadIdx.x == 0) (void)xb_add(&bar[XB_XCNT(b.x)], 1u);
    return b;
}
__device__ __forceinline__ void xcd_barrier_complete(unsigned* bar, unsigned x, unsigned& nloc, unsigned& nx) {
    const unsigned G = gridDim.x * gridDim.y * gridDim.z;
    unsigned sum, cnt, mine, sp = 0u;
    for (;;) {
        sum = 0u; cnt = 0u; mine = 0u;
#pragma unroll
        for (unsigned j = 0; j < 16; ++j) { const unsigned c = xb_ld(&bar[XB_XCNT(j)]); sum += c; cnt += (c > 0u) ? 1u : 0u; mine = (j == x) ? c : mine; }
        if (sum == G) break;
        __builtin_amdgcn_s_sleep(1);
        if ((++sp & 255u) == 0u) { if (xb_ld(&bar[XB_TMO])) break; if (sp > XB_SPIN_CAP) { atomicAdd(&bar[XB_TMO], 1u); break; } }
    }
    nloc = mine > 0u ? mine : 1u; nx = cnt > 0u ? cnt : 1u;
}

__device__ __forceinline__ void xcd_barrier(const XcdBarrier& b) {
    asm volatile("s_waitcnt vmcnt(0)" ::: "memory");
    __syncthreads();
    if (threadIdx.x == 0) {
        unsigned* bar = b.bar;
        __builtin_amdgcn_s_waitcnt(0);
        unsigned nloc = b.st[0], nx = b.st[1];
        if (nloc == 0u) { xcd_barrier_complete(bar, b.x, nloc, nx); b.st[0] = nloc; b.st[1] = nx; }
        const unsigned old = xb_add(&bar[XB_XSUB(b.x)], 1u);
        const unsigned gen = old / nloc;
        if (old + 1u == (gen + 1u) * nloc) {
            __builtin_amdgcn_fence(__ATOMIC_RELEASE, "agent");
            asm volatile("s_waitcnt vmcnt(0)" ::: "memory");
            const unsigned og = xb_add(&bar[XB_TOP], 1u);
            const unsigned tg = og / nx;
            if (og + 1u == (tg + 1u) * nx) xb_add(&bar[XB_TOPGEN], 1u);
            else XB_SPIN(xb_ld(&bar[XB_TOPGEN]) == tg, bar);
            __builtin_amdgcn_fence(__ATOMIC_ACQUIRE, "agent");
            xb_add(&bar[XB_XGEN(b.x)], 1u);
            asm volatile("s_waitcnt vmcnt(0)" ::: "memory");
        } else {
            XB_SPIN(xb_ld(&bar[XB_XGEN(b.x)]) == gen, bar);
            __builtin_amdgcn_fence(__ATOMIC_ACQUIRE, "agent");
            asm volatile("s_waitcnt vmcnt(0)" ::: "memory");
        }
    }
    __syncthreads();
}


template <int MASK> __global__ void __launch_bounds__(512, 2) mega_fwd(Args ka) {
    extern __shared__ __attribute__((aligned(16))) unsigned char lds_raw[];
    LAS unsigned char* lds = (LAS unsigned char*)lds_raw;
    cg::grid_group grid = cg::this_grid();
    volatile LAS unsigned* bst = (volatile LAS unsigned*)(lds + 131072);
    if (threadIdx.x < 2) bst[threadIdx.x] = 0u;
    __syncthreads();
    const XcdBarrier xbar = xcd_barrier_post((unsigned*)(ka.ws + OFF_BAR), bst);
    if (ka.ph_lo == 0) {
        if (threadIdx.x == 0) { long long* tb = (long long*)(ka.ws + OFF_PTRS);
#pragma unroll
            for (int i = 0; i < 26; ++i) tb[i] = (long long)((const unsigned char*)ka.in[i] - ka.ws);
            tb[26] = (long long)((const unsigned char*)ka.out - ka.ws); }
        __syncthreads();
    }
#ifdef DUP_MASK
    int ph = ka.ph_lo - 1, rep = 1;
    for (;;) {
        if (rep == 0 && ph > 0 && ((DUP_MASK >> ((ph - 1) % 11)) & 1)) rep = 1; else { rep = 0; ++ph; }
        if (ph >= ka.ph_hi) break;
        if (ph > 0 && ((ph - 1) % 11 == 6 || (ph - 1) % 11 == 10)) continue;
        if (ph > ka.ph_lo) { if (ph == ka.ph_lo + 1) grid.sync(); else xcd_barrier(xbar); }
#ifdef EXTRA_SYNCS
        for (int es = 0; es < EXTRA_SYNCS; ++es) grid.sync();
#endif
#else
    for (int ph = ka.ph_lo; ph < ka.ph_hi; ++ph) {
        if (ph > 0 && ((ph - 1) % 11 == 6 || (ph - 1) % 11 == 10)) continue;
        if (ph > ka.ph_lo) { if (ph == ka.ph_lo + 1) grid.sync(); else xcd_barrier(xbar); }
#endif
        int tid_o = threadIdx.x; asm volatile("" : "+v"(tid_o));
        const int tid = tid_o, lane = tid & 63, wid = __builtin_amdgcn_readfirstlane(tid >> 6);
        size_t zoff = 0; asm volatile("" : "+s"(zoff));
        unsigned char* ws = ka.ws + zoff;
        const float epsv = __uint_as_float(0x358637bdu + (unsigned)zoff);
        int G = gridDim.x, cu = blockIdx.x; asm volatile("" : "+s"(G), "+s"(cu));
        const Ctx a{ws, (const long long*)(ws + OFF_PTRS), (float*)(ws + ((const long long*)(ws + OFF_PTRS))[26])};
        bf16_t* Wb = (bf16_t*)(ws + WS_W);
        float* ssx = (float*)(ws + WS_SSX); unsigned long long* gran = (unsigned long long*)(ws + WS_GRAN); float* ssq = (float*)(ws + OFF_SSQ); float* sskv = (float*)(ws + OFF_SSKV); float* ssy = (float*)(ws + OFF_SSY);
        const float* rope = (const float*)(ws + OFF_ROPE);
        bf16_t* XY = (bf16_t*)(ws + WS_XY);
        if (ph == 0) { if constexpr ((MASK >> 11) & 1) { init_phase(a, tid, wid, lane, G, cu, epsv); prep_layer(a, 0, lds, tid, wid, lane, G, cu, 0); } continue; }
        const int l = (ph - 1) / 11, sp = (ph - 1) % 11;
        switch (sp) {
        case 0: if constexpr ((MASK >> 0) & 1) {
            Gemm g{XY, Wb + WE_IN, DM, DM, DM, 0, 0}; StaticOrder S; S.init(T_TOK, INP, G, cu);
            EpiIn E{ssx, epsv, (bf16_t*)(ws + WS_CQ), (bf16_t*)(ws + WS_KPE), (bf16_t*)(ws + WS_CKV), (bf16_t*)(ws + WS_UP), (bf16_t*)(ws + WS_GATES), a.inp(I_BGATE) + (size_t)l * 2048, ssq, sskv, rope};
            gemm_phase<EpiIn, StaticOrder, true, true>(lds, g, S, E);
            if (cu >= G / 2) prep_layer(a, l, lds, tid, wid, lane, G, cu, 1);
        } break;
        case 1: if constexpr ((MASK >> 1) & 1) {
            if constexpr ((MASK >> 12) & 1) { Gemm g{(const bf16_t*)(ws + WS_CQ), Wb + WE_UQ, QL, QL, QL, 0, 0}; StaticOrder S; S.init(T_TOK, 768, G, cu);
              EpiQ E{ssq, (bf16_t*)(ws + WS_Q), rope, 0.10206207261596577f * 1.4426950408889634f, epsv};
              gemm_phase<EpiQ, StaticOrder, true, true>(lds, g, S, E); }
            if constexpr ((MASK >> 13) & 1) { Gemm g{(const bf16_t*)(ws + WS_UP), Wb + WE_WST, KS5, 512, 512, (size_t)NCHR * KS5, (size_t)256 * 512}; BatchOrder S; S.init(NCHR, 256, NGRP, G, (cu + G / 2) % G);
              EpiState E{(float*)(ws + WS_SST)};
              gemm_phase<EpiState, BatchOrder, true, true>(lds, g, S, E); }
            if constexpr ((MASK >> 14) & 1) { Gemm g{(const bf16_t*)(ws + WS_CKV), Wb + WE_UKV, KVL, KVL, KVL, 0, 0}; StaticOrder S; S.init(T_TOK, 1024, G, cu);
              EpiKV E{sskv, (bf16_t*)(ws + WS_KN), (bf16_t*)(ws + WS_V), epsv};
              gemm_phase<EpiKV, StaticOrder, true, true>(lds, g, S, E); }
        } break;
        case 2: if constexpr ((MASK >> 2) & 1) {
            carry_phase(a, tid, G, cu);
            attn_phase(a, lds, tid, wid, lane, G, cu);
        } break;
        case 3: if constexpr ((MASK >> 3) & 1) {
            { Gemm g{(const bf16_t*)(ws + WS_O), Wb + WE_OATT, 512, 512, 512, 0, 0}; StaticOrder S; S.init(T_TOK, DM, G, cu);
              EpiOatt E{(const bf16_t*)(ws + WS_GATES), (bf16_t*)(ws + WS_MERGED)};
              gemm_phase<EpiOatt, StaticOrder, true, true>(lds, g, S, E); }
            { Gemm g{(const bf16_t*)(ws + WS_UP), Wb + WE_TV, KS5, KS5, KS5, (size_t)NCHR * KS5, (size_t)512 * KS5}; BatchOrder S; S.init(NCHR, 512, NGRP, G, cu);
              EpiS5 E{(bf16_t*)(ws + WS_YS5)};
              gemm_phase<EpiS5, BatchOrder, true, true>(lds, g, S, E); }
        } break;
        case 4: if constexpr ((MASK >> 4) & 1) {
            Gemm g{(const bf16_t*)(ws + WS_YS5), Wb + WE_GLU, SSMW, SSMW, SSMW, 0, 0}; StaticOrder S; S.init(T_TOK, 2048, G, cu);
            EpiGlu E{(const bf16_t*)(ws + WS_GATES), (bf16_t*)(ws + WS_MERGED)};
            gemm_phase<EpiGlu, StaticOrder, true, true>(lds, g, S, E);
        } break;
        case 5: if constexpr ((MASK >> 5) & 1) {
            Gemm g{(const bf16_t*)(ws + WS_MERGED), Wb + WE_OUT, DM, DM, DM, 0, 0}; StaticOrder S; S.init(T_TOK, DM, G, cu);
            EpiYN E{XY, nullptr, a.inp(I_GMIXPOST) + (size_t)l * DM, gran, ssx, (unsigned)(l * 2 + 1), epsv, (LAS float*)(lds + 131072 + 64)};
            gemm_phase<EpiYN, StaticOrder, true, true>(lds, g, S, E);
        } break;
        case 6: break;
        case 7: if constexpr ((MASK >> 7) & 1) {
            Gemm g{XY, Wb + WE_UP, DM, DM, DM, 0, 0}; StaticOrder S; S.init(T_TOK, 2 * DFF, G, cu);
            EpiUpConv E{ssx, epsv, a.inp(I_CONVW) + (size_t)l * 3 * DFF, a.inp(I_CONVB) + (size_t)l * DFF, (bf16_t*)(ws + WS_VAL), (float*)(ws + WS_GL), (float*)(ws + WS_GF), (float*)(ws + WS_VF), (LAS float*)(lds + 131072 + 64)};
            gemm_phase<EpiUpConv, StaticOrder, true, true>(lds, g, S, E);
        } break;
        case 8: if constexpr ((MASK >> 8) & 1) { conv_fixup_phase(a, l, tid, G, cu);
            if (l + 1 < DEPTH) prep_layer(a, l + 1, lds, tid, wid, lane, G, cu, 0);
        } break;
        case 9: if constexpr ((MASK >> 9) & 1) {
            Gemm g{(const bf16_t*)(ws + WS_VAL), Wb + WE_DOWN, DFF, DFF, DFF, 0, 0}; StaticOrder S; S.init(T_TOK, DM, G, cu);
            EpiYN E{XY, (l + 1 == DEPTH) ? a.out : nullptr, a.inp(I_GFFNPOST) + (size_t)l * DM, gran, ssx, (unsigned)(l * 2 + 2), epsv, (LAS float*)(lds + 131072 + 64)};
            gemm_phase<EpiYN, StaticOrder, true, true>(lds, g, S, E);
        } break;
        case 10: if constexpr ((MASK >> 10) & 1) {
        } break;
        }
    }
}

#ifndef N_LAUNCH_MODE
#define N_LAUNCH_MODE 1
#endif
#ifndef GEMM_MASK_V
#define GEMM_MASK_V 0x7ABB
#endif
constexpr int GEMM_MASK = GEMM_MASK_V, OTHER_MASK = 0xD44;
extern "C" void kernel_launch(void* const* d_in, const int* in_sizes, int n_in, void* d_out, int out_size, void* d_ws, size_t ws_size, hipStream_t stream) {
    static int grid = 0;
    if (grid == 0) {
        if (n_in != 26 || out_size != T_TOK * DM || ws_size < WS_END) { fprintf(stderr, "kernel_launch: unexpected shapes (n_in %d out %d ws %zu)\n", n_in, out_size, ws_size); grid = -1; return; }
        int dev = 0, cus = 0;
        (void)hipGetDevice(&dev); (void)hipDeviceGetAttribute(&cus, hipDeviceAttributeMultiprocessorCount, dev);
#if N_LAUNCH_MODE == 1
        (void)hipFuncSetAttribute((const void*)mega_fwd<0x7FFF>, hipFuncAttributeMaxDynamicSharedMemorySize, LDS_BYTES);
#else
        (void)hipFuncSetAttribute((const void*)mega_fwd<GEMM_MASK>, hipFuncAttributeMaxDynamicSharedMemorySize, LDS_BYTES);
        (void)hipFuncSetAttribute((const void*)mega_fwd<OTHER_MASK>, hipFuncAttributeMaxDynamicSharedMemorySize, LDS_BYTES);
#endif
        grid = cus > 0 ? cus : 256;
        (void)hipGetLastError();
    }
    if (grid < 0) return;
    Args a{};
    for (int i = 0; i < 26; ++i) a.in[i] = (const float*)d_in[i];
    a.out = (float*)d_out; a.ws = (unsigned char*)d_ws;
#if N_LAUNCH_MODE == 1
    a.ph_lo = 0; a.ph_hi = 1 + 11 * DEPTH;
    (void)hipMemsetAsync((char*)d_ws + OFF_BAR, 0, XCD_BAR_WORDS * 4, stream);
    (void)hipMemsetAsync((char*)d_ws + WS_GRAN, 0, GRAN_BYTES, stream);
    void* args[] = {&a};
    hipError_t e = hipLaunchCooperativeKernel((const void*)mega_fwd<0x7FFF>, dim3(grid), dim3(512), args, LDS_BYTES, stream);
    if (e != hipSuccess) fprintf(stderr, "cooperative launch failed: %s (grid %d)\n", hipGetErrorString(e), grid);
#else
    for (int ph = 0; ph < 1 + 11 * DEPTH; ++ph) {
        a.ph_lo = ph; a.ph_hi = ph + 1;
        const int sp = ph == 0 ? 11 : (ph - 1) % 11;
        if ((0x2BB >> sp) & 1) hipLaunchKernelGGL(mega_fwd<GEMM_MASK>, dim3(grid), dim3(512), LDS_BYTES, stream, a);
        else hipLaunchKernelGGL(mega_fwd<OTHER_MASK>, dim3(grid), dim3(512), LDS_BYTES, stream, a);
    }
#endif
}
```

```cpp
#include <hip/hip_runtime.h>
#include <hip/hip_cooperative_groups.h>
#include <cstdio>
#include <cstdint>
namespace cg = cooperative_groups;

#define LAS __attribute__((address_space(3)))
#define PG8_LAS __attribute__((address_space(3)))
typedef unsigned short bf16_t;
typedef short bf16x8 __attribute__((ext_vector_type(8)));
typedef short s16x4 __attribute__((ext_vector_type(4)));
typedef float f32x4 __attribute__((ext_vector_type(4)));
typedef float f32x2 __attribute__((ext_vector_type(2)));
typedef unsigned u32x4 __attribute__((ext_vector_type(4)));
typedef unsigned u32x2 __attribute__((ext_vector_type(2)));

constexpr int T_TOK = 32768, DM = 1024, SEQ = 2048, NBATCH = 16, DEPTH = 4;
constexpr int QL = 384, KVL = 256, ROPE_D = 32, SSMW = 512, INC = 3232, INP = 3328;
constexpr int NHEAD = 8, QKD = 96, DFF = 2816;
constexpr int LCH = 32, NCHR = T_TOK / LCH  , KS5 = 640, NGRP = 32, NST = 64;
constexpr float EPS = 1e-6f;

constexpr int BM = 256, BK = 64, HALF = 128, HTB = HALF * BK * 2, STAGE_BYTES = 8 * HTB, NXCD = 8, WGM = 8;

__host__ __device__ __forceinline__ int lds_byte(int r, int c) { const int st = (r >> 4) * 2 + (c >> 5), rr = r & 15, cc = c & 31, ob = rr * 64 + cc * 2; return st * 1024 + (ob ^ (((ob >> 9) & 1) << 5)); }
__host__ __device__ __forceinline__ void stage_rc(int b, int& R, int& C) { const int st = b / 1024, sb = b % 1024, swz = sb ^ (((sb >> 9) & 1) << 5); R = (st >> 1) * 16 + swz / 64; C = (st & 1) * 32 + (swz % 64) / 2; }
__host__ __device__ __forceinline__ int perm32(int rho) { const int n = rho >> 4, i = rho & 15; return 8 * (i >> 2) + 4 * n + (i & 3); }

struct Unit { int pm, pn, z; };
struct Gemm { const bf16_t* A; const bf16_t* Bt; int lda, ldb, K; size_t zA, zB; };

struct StaticOrder {
    int nM, nN, nwg, G, c;
    __host__ __device__ void init(int M, int N, int G_, int c_) { nM = M / BM; nN = N / BM; nwg = nM * nN; G = G_; c = c_; }
    __host__ __device__ bool next(int i, Unit& u) const {
        const long L = (long)i * G + c; if (L >= nwg) return false;
        int wgid = (int)L; { const int q = nwg / NXCD, r = nwg % NXCD, xcd = wgid % NXCD, off = wgid / NXCD; wgid = (xcd < r ? xcd * (q + 1) : r * (q + 1) + (xcd - r) * q) + off; }
        const int nig = WGM * nN, gid = wgid / nig, fm = gid * WGM, gsz = (nM - fm) < WGM ? (nM - fm) : WGM;
        u.pm = fm + ((wgid % nig) % gsz); u.pn = (wgid % nig) / gsz; u.z = 0; return true;
    }
    __device__ __forceinline__ void a_ready(const Unit&) const {}
    __device__ __forceinline__ void done(const Unit&) const {}
};
struct BatchOrder {
    int nM, nN, nz, G, c;
    __host__ __device__ void init(int M, int N, int nz_, int G_, int c_) { nM = M / BM; nN = N / BM; nz = nz_; G = G_; c = c_; }
    __host__ __device__ bool next(int i, Unit& u) const {
        const long L = (long)i * G + c; if (L >= (long)nz * nM * nN) return false;
        const int per = nM * nN; u.z = (int)(L / per); const int r = (int)(L % per); u.pn = r / nM; u.pm = r % nM; return true;
    }
    __device__ __forceinline__ void a_ready(const Unit&) const {}
    __device__ __forceinline__ void done(const Unit&) const {}
};

typedef __bf16 bf16x2_t __attribute__((ext_vector_type(2)));
__device__ __forceinline__ unsigned cvt_pk_bf16(float lo, float hi) { const f32x2 v = {lo, hi}; const bf16x2_t b = __builtin_convertvector(v, bf16x2_t); return __builtin_bit_cast(unsigned, b); }
__device__ __forceinline__ float bf_lo(unsigned w) { return __uint_as_float(w << 16); }
__device__ __forceinline__ float bf_hi(unsigned w) { return __uint_as_float(w & 0xffff0000u); }
__device__ __forceinline__ float shx(float x, int k, int lane) { return __builtin_bit_cast(float, __builtin_amdgcn_ds_bpermute((lane ^ k) << 2, __builtin_bit_cast(int, x))); }
__device__ __forceinline__ float sigmoid_f(float x) { return __builtin_amdgcn_rcpf(1.0f + __builtin_amdgcn_exp2f(x * -1.4426950408889634f)); }
__device__ __forceinline__ float gelu_tanh(float x) {
    const float K1 = 2.0f * 0.7978845608028654f * 1.4426950408889634f, K2 = K1 * 0.044715f;
    const float a = fmaf(x * x, K2, K1); return x * __builtin_amdgcn_rcpf(1.0f + __builtin_amdgcn_exp2f(-x * a)); }
__device__ __forceinline__ u32x4 pack8(const f32x4 a, const f32x4 b) { u32x4 w; w.x = cvt_pk_bf16(a[0], a[1]); w.y = cvt_pk_bf16(a[2], a[3]); w.z = cvt_pk_bf16(b[0], b[1]); w.w = cvt_pk_bf16(b[2], b[3]); return w; }

template <class Epi, class Sched, bool ALIGN_EPI = false, bool SP2 = false>
__device__ __forceinline__ void gemm_phase(PG8_LAS unsigned char* lds, const Gemm g, const Sched& S, const Epi& E) {
    int tid_o = threadIdx.x; asm volatile("" : "+v"(tid_o));
    const int tid = tid_o, wid = __builtin_amdgcn_readfirstlane(tid >> 6), lane = tid & 63, wr = wid >> 2, wc = wid & 3, fr = lane & 15, fq = lane >> 4;
    const int K = g.K, nt = K / BK;
    unsigned voffA[2], voffB[2];
#pragma unroll
    for (int i = 0; i < 2; ++i) { int R, C; stage_rc(tid * 16 + i * 8192, R, C); const int Rb = Epi::PERM ? ((R & ~31) + perm32(R & 31)) : R;
        voffA[i] = (unsigned)(R * g.lda + C) * 2u; voffB[i] = (unsigned)(Rb * g.ldb + C) * 2u; }
    const size_t kstep = (size_t)(BK * 2);
    const size_t hstepA = (size_t)HALF * g.lda * 2, hstepB = (size_t)HALF * g.ldb * 2;
    const size_t tstepA = 2 * hstepA, tstepB = 2 * hstepB;
    const unsigned ldsw = (unsigned)wid * 1024u;
    const int aoff = lds_byte(wr * 64 + fr, fq * 8), boff = lds_byte(wc * 32 + fr, fq * 8);
#define PG8_SA(b, h) (((b) * 2 + (h)) * HTB)
#define PG8_SB(b, h) ((4 + (b) * 2 + (h)) * HTB)
#define PG8_STAGE(bufoff, gbase, voff) do { _Pragma("unroll") for (int _i = 0; _i < 2; ++_i) \
        __builtin_amdgcn_global_load_lds((const unsigned*)((const char*)(gbase) + (voff)[_i]), (PG8_LAS unsigned*)(lds + (bufoff) + ldsw + _i * 8192), 16, 0, 0); } while (0)
#define PG8_LDA(dst, b, h) do { _Pragma("unroll") for (int m = 0; m < 4; ++m) _Pragma("unroll") for (int k = 0; k < 2; ++k) dst[m][k] = *(const PG8_LAS bf16x8*)(lds + PG8_SA(b, h) + aoff + m * 2048 + k * 1024); } while (0)
#define PG8_LDB(dst, b, h) do { _Pragma("unroll") for (int n = 0; n < 2; ++n) _Pragma("unroll") for (int k = 0; k < 2; ++k) dst[n][k] = *(const PG8_LAS bf16x8*)(lds + PG8_SB(b, h) + boff + n * 2048 + k * 1024); } while (0)
#define PG8_MMA(ai, bj, At, Bt) do { __builtin_amdgcn_s_setprio(1); _Pragma("unroll") for (int m = 0; m < 4; ++m) _Pragma("unroll") for (int n = 0; n < 2; ++n) _Pragma("unroll") for (int k = 0; k < 2; ++k) \
        acc[ai][bj][m][n] = __builtin_amdgcn_mfma_f32_16x16x32_bf16(Bt[n][k], At[m][k], acc[ai][bj][m][n], 0, 0, 0); __builtin_amdgcn_s_setprio(0); } while (0)
#define PG8_WAIT_V(n) asm volatile("s_waitcnt vmcnt(" #n ")" ::: "memory")
#define PG8_WAIT_L(n) asm volatile("s_waitcnt lgkmcnt(" #n ")" ::: "memory")
#define PG8_BAR __builtin_amdgcn_s_barrier()
#define PG8_SCHED __builtin_amdgcn_sched_barrier(0)
    Unit cur, nxt; int ui = 0;
    if (!S.next(0, cur)) return;
    f32x4 acc[2][2][4][2];
#pragma unroll
    for (int a = 0; a < 2; ++a)
#pragma unroll
        for (int b = 0; b < 2; ++b)
#pragma unroll
            for (int m = 0; m < 4; ++m)
#pragma unroll
                for (int n = 0; n < 2; ++n) acc[a][b][m][n] = (f32x4){0.f, 0.f, 0.f, 0.f};
    bf16x8 At[4][2], B0[2][2], B1[2][2];
    const char* cA = (const char*)g.A + (size_t)cur.z * g.zA * 2 + (size_t)cur.pm * tstepA; const char* cB = (const char*)g.Bt + (size_t)cur.z * g.zB * 2 + (size_t)cur.pn * tstepB;
    S.a_ready(cur);
    if constexpr (SP2) {
        PG8_STAGE(PG8_SB(0, 0), cB, voffB); PG8_STAGE(PG8_SB(0, 1), cB + hstepB, voffB); PG8_STAGE(PG8_SA(0, 0), cA, voffA); PG8_STAGE(PG8_SA(0, 1), cA + hstepA, voffA);
        if (wr == 1) PG8_BAR;
        PG8_WAIT_V(2); PG8_BAR;
        PG8_STAGE(PG8_SB(1, 0), cB + kstep, voffB); PG8_STAGE(PG8_SA(1, 0), cA + kstep, voffA); PG8_STAGE(PG8_SB(1, 1), cB + hstepB + kstep, voffB);
        PG8_WAIT_V(6); PG8_BAR;
    } else {
        PG8_STAGE(PG8_SB(0, 0), cB, voffB); PG8_STAGE(PG8_SA(0, 0), cA, voffA); PG8_STAGE(PG8_SB(0, 1), cB + hstepB, voffB); PG8_STAGE(PG8_SA(0, 1), cA + hstepA, voffA);
        if (wr == 1) PG8_BAR;
        PG8_WAIT_V(4); PG8_BAR;
        PG8_STAGE(PG8_SB(1, 0), cB + kstep, voffB); PG8_STAGE(PG8_SA(1, 0), cA + kstep, voffA); PG8_STAGE(PG8_SB(1, 1), cB + hstepB + kstep, voffB);
        PG8_WAIT_V(6); PG8_BAR;
    }
    for (;;) {
        const bool has_next = S.next(ui + 1, nxt);
        const char* nA = has_next ? (const char*)g.A + (size_t)nxt.z * g.zA * 2 + (size_t)nxt.pm * tstepA : cA; const char* nB = has_next ? (const char*)g.Bt + (size_t)nxt.z * g.zB * 2 + (size_t)nxt.pn * tstepB : cB;
        for (int t = 0; t < nt; t += 2) {
            const bool last = (t == nt - 2);
            const char* a1 = cA + (size_t)(t + 1) * kstep;
            const char* a2 = last ? nA : cA + (size_t)(t + 2) * kstep; const char* b2 = last ? nB : cB + (size_t)(t + 2) * kstep;
            const char* a3 = a2 + kstep; const char* b3 = b2 + kstep;
            if (last && has_next) S.a_ready(nxt);
            if constexpr (SP2) {
            PG8_LDB(B0, 0, 0); PG8_LDB(B1, 0, 1); PG8_SCHED; PG8_LDA(At, 0, 0); PG8_STAGE(PG8_SA(1, 1), a1 + hstepA, voffA);
            PG8_WAIT_V(8); PG8_WAIT_L(0); PG8_BAR; PG8_MMA(0, 0, At, B0); PG8_MMA(0, 1, At, B1); PG8_BAR; PG8_SCHED;
            PG8_LDA(At, 0, 1); PG8_STAGE(PG8_SB(0, 0), b2, voffB); PG8_STAGE(PG8_SB(0, 1), b2 + hstepB, voffB); PG8_STAGE(PG8_SA(0, 0), a2, voffA);
            PG8_WAIT_V(8); PG8_WAIT_L(0); PG8_BAR; PG8_MMA(1, 0, At, B0); PG8_MMA(1, 1, At, B1); PG8_BAR; PG8_SCHED;
            PG8_LDB(B0, 1, 0); PG8_LDB(B1, 1, 1); PG8_SCHED; PG8_LDA(At, 1, 0); PG8_STAGE(PG8_SA(0, 1), a2 + hstepA, voffA);
            PG8_WAIT_V(8); PG8_WAIT_L(0); PG8_BAR; PG8_MMA(0, 0, At, B0); PG8_MMA(0, 1, At, B1); PG8_BAR; PG8_SCHED;
            PG8_LDA(At, 1, 1); PG8_STAGE(PG8_SB(1, 0), b3, voffB); PG8_STAGE(PG8_SB(1, 1), b3 + hstepB, voffB); PG8_STAGE(PG8_SA(1, 0), a3, voffA);
            PG8_WAIT_V(8); PG8_WAIT_L(0); PG8_BAR; PG8_MMA(1, 0, At, B0); PG8_MMA(1, 1, At, B1); PG8_BAR; PG8_SCHED;
            } else {
            PG8_LDB(B0, 0, 0); PG8_SCHED; PG8_LDA(At, 0, 0); PG8_STAGE(PG8_SA(1, 1), a1 + hstepA, voffA);
            PG8_WAIT_L(8); PG8_BAR; PG8_WAIT_L(0); PG8_MMA(0, 0, At, B0); PG8_BAR; PG8_SCHED;
            PG8_LDB(B1, 0, 1); PG8_STAGE(PG8_SB(0, 0), b2, voffB);
            PG8_BAR; PG8_WAIT_L(0); PG8_MMA(0, 1, At, B1); PG8_BAR;
            PG8_LDA(At, 0, 1); PG8_STAGE(PG8_SA(0, 0), a2, voffA);
            PG8_BAR; PG8_WAIT_L(0); PG8_MMA(1, 0, At, B0); PG8_BAR; PG8_SCHED;
            PG8_STAGE(PG8_SB(0, 1), b2 + hstepB, voffB);
            PG8_WAIT_V(6); PG8_BAR; PG8_MMA(1, 1, At, B1); PG8_BAR;
            PG8_LDB(B0, 1, 0); PG8_SCHED; PG8_LDA(At, 1, 0); PG8_STAGE(PG8_SA(0, 1), a2 + hstepA, voffA);
            PG8_WAIT_L(8); PG8_BAR; PG8_WAIT_L(0); PG8_MMA(0, 0, At, B0); PG8_BAR; PG8_SCHED;
            PG8_LDB(B1, 1, 1); PG8_STAGE(PG8_SB(1, 0), b3, voffB);
            PG8_BAR; PG8_WAIT_L(0); PG8_MMA(0, 1, At, B1); PG8_BAR;
            PG8_LDA(At, 1, 1); PG8_STAGE(PG8_SA(1, 0), a3, voffA);
            PG8_BAR; PG8_WAIT_L(0); PG8_MMA(1, 0, At, B0); PG8_BAR; PG8_SCHED;
            PG8_STAGE(PG8_SB(1, 1), b3 + hstepB, voffB);
            PG8_WAIT_V(6); PG8_BAR; PG8_MMA(1, 1, At, B1); PG8_BAR;
            }
        }
        if constexpr (ALIGN_EPI) { if (wr == 0) PG8_BAR; }
        if constexpr (!Epi::AFTER_DRAIN) { int lane_e; asm volatile("v_mbcnt_lo_u32_b32 %0, -1, 0\n\tv_mbcnt_hi_u32_b32 %0, -1, %0" : "=v"(lane_e)); E(acc, cur, wr, wc, lane_e & 15, lane_e >> 4); S.done(cur); }
        if (!has_next) break;
#pragma unroll
        for (int a = 0; a < 2; ++a)
#pragma unroll
            for (int b = 0; b < 2; ++b)
#pragma unroll
                for (int m = 0; m < 4; ++m)
#pragma unroll
                    for (int n = 0; n < 2; ++n) acc[a][b][m][n] = (f32x4){0.f, 0.f, 0.f, 0.f};
        cur = nxt; cA = nA; cB = nB; ++ui;
        if constexpr (ALIGN_EPI) { if (wr == 1) PG8_BAR; }
    }
    PG8_WAIT_V(0);
    if constexpr (!ALIGN_EPI) { if (wr == 0) PG8_BAR; }
    PG8_BAR;
    if constexpr (Epi::AFTER_DRAIN) { E.fused(acc, cur, wr, wc, fr, fq, lds, wid, lane); S.done(cur); }
#undef PG8_SA
#undef PG8_SB
#undef PG8_STAGE
#undef PG8_LDA
#undef PG8_LDB
#undef PG8_MMA
#undef PG8_WAIT_V
#undef PG8_WAIT_L
#undef PG8_BAR
#undef PG8_SCHED
}

constexpr size_t MiB = (size_t)1 << 20;
constexpr size_t OFF_RSTDX = 0, OFF_ROPE = 128 * 1024, OFF_AL = 384 * 1024, OFF_PTRS = 448 * 1024, OFF_BAR = 456 * 1024  , OFF_SSKV = 512 * 1024  , OFF_SSQ = 1024 * 1024  , OFF_SSY = 2048 * 1024  ;
constexpr size_t WS_W = 4 * MiB;
constexpr size_t WE_IN = 0, WE_UQ = 3407872, WE_UKV = 3702784, WE_OATT = 3964928, WE_GLU = 4489216, WE_OUT = 5537792, WE_UP = 6586368, WE_DOWN = 12353536, WE_TV = 15237120, WE_WST = 25722880;
constexpr size_t WS_SSX = 62 * MiB  , WS_SST4 = 61 * MiB + 512 * 1024  , WS_GRAN = 65 * MiB  , GRAN_BYTES = 4 * (size_t)32768 * 8;
constexpr size_t WS_XY = 68 * MiB;
constexpr size_t WS_GATES = 132 * MiB, WS_CQ = 260 * MiB, WS_CKV = 284 * MiB, WS_KPE = 300 * MiB, WS_UP = 302 * MiB, WS_Q = 342 * MiB, WS_KN = 390 * MiB, WS_V = 422 * MiB, WS_SST = 454 * MiB;
constexpr size_t WS_O = 260 * MiB, WS_MERGED = 342 * MiB, WS_YS5 = 422 * MiB;
constexpr size_t WS_G = 132 * MiB, WS_VAL = 308 * MiB;
constexpr size_t WS_YB = 132 * MiB;
constexpr size_t WS_GL = 484 * MiB, WS_GF = 488 * MiB, WS_VF = 492 * MiB;
constexpr size_t WS_END = 496 * MiB;

constexpr int LDS_BYTES = 131072 + 64 + 16384 + 64;
#ifndef PHMASK
#define PHMASK 0xFFF
#endif

#define EPI_ROWS_BEGIN _Pragma("unroll") for (int ai = 0; ai < 2; ++ai) _Pragma("unroll") for (int m = 0; m < 4; ++m) { const int row = u.pm * BM + ai * HALF + wr * 64 + m * 16 + fr;
#define EPI_ROWS_END }
__device__ __forceinline__ float sumsq8(const f32x4 a, const f32x4 b) { return (a[0] * a[0] + a[1] * a[1]) + (a[2] * a[2] + a[3] * a[3]) + (b[0] * b[0] + b[1] * b[1]) + (b[2] * b[2] + b[3] * b[3]); }
__device__ __forceinline__ void rope8(f32x4& v0, f32x4& v1, const float* rope, int pos, int fq) {
    const f32x4 cs0 = *(const f32x4*)(rope + (pos * 16 + 4 * fq) * 2), cs1 = *(const f32x4*)(rope + (pos * 16 + 4 * fq) * 2 + 4);
    const float c[4] = {cs0[0], cs0[2], cs1[0], cs1[2]}, s[4] = {cs0[1], cs0[3], cs1[1], cs1[3]};
    f32x4 o0, o1;
#pragma unroll
    for (int j = 0; j < 4; ++j) { o0[j] = v0[j] * c[j] - v1[j] * s[j]; o1[j] = v1[j] * c[j] + v0[j] * s[j]; }
    v0 = o0; v1 = o1;
}

__device__ __forceinline__ float row_rstd(const float* ssx, int row, float epsv, int lane, int fq) {
    const f32x4 a = *(const f32x4*)(ssx + (unsigned)row * 16 + 4 * fq); float t = (a[0] + a[1]) + (a[2] + a[3]); t += shx(t, 16, lane); t += shx(t, 32, lane);
    return rsqrtf(t * (1.0f / DM) + epsv);
}
struct EpiIn {
    static constexpr bool PERM = true, AFTER_DRAIN = false;
    const float* ssx; float epsv; bf16_t* CQ; bf16_t* KPE; bf16_t* CKV; bf16_t* UP; bf16_t* GATES; const float* bgate; float* ssq; float* sskv; const float* rope;
    __device__ __forceinline__ void operator()(const f32x4 (&acc)[2][2][4][2], const Unit& u, int wr, int wc, int fr, int fq) const {
        const int pn = u.pn;
        EPI_ROWS_BEGIN
            const float rs = row_rstd(ssx, row, epsv, fr | (fq << 4), fq);
            if (pn == 0) {
                float ss = 0.f;
#pragma unroll
                for (int bj = 0; bj < 2; ++bj) { const f32x4 v0 = acc[ai][bj][m][0] * rs, v1 = acc[ai][bj][m][1] * rs; ss += sumsq8(v0, v1);
                    *(u32x4*)(CQ + (unsigned)row * QL + bj * HALF + wc * 32 + fq * 8) = pack8(v0, v1); }
                ss += shx(ss, 16, fr | (fq << 4)); ss += shx(ss, 32, fr | (fq << 4));
                if (fq == 0) ssq[row * 8 + wc] = ss;
            } else if (pn == 1) {
                { const f32x4 v0 = acc[ai][0][m][0] * rs, v1 = acc[ai][0][m][1] * rs; float ss = sumsq8(v0, v1);
                  *(u32x4*)(CQ + (unsigned)row * QL + 256 + wc * 32 + fq * 8) = pack8(v0, v1);
                  ss += shx(ss, 16, fr | (fq << 4)); ss += shx(ss, 32, fr | (fq << 4));
                  if (fq == 0) ssq[row * 8 + 4 + wc] = ss; }
                if (wc == 0) { f32x4 v0 = acc[ai][1][m][0] * rs, v1 = acc[ai][1][m][1] * rs; rope8(v0, v1, rope, row & (SEQ - 1), fq);
                  *(u32x4*)(KPE + (unsigned)row * ROPE_D + fq * 8) = pack8(v0, v1); }
            } else if (pn == 2) {
                float ss = 0.f;
#pragma unroll
                for (int bj = 0; bj < 2; ++bj) { const f32x4 v0 = acc[ai][bj][m][0] * rs, v1 = acc[ai][bj][m][1] * rs; ss += sumsq8(v0, v1);
                    *(u32x4*)(CKV + (unsigned)row * KVL + bj * HALF + wc * 32 + fq * 8) = pack8(v0, v1); }
                ss += shx(ss, 16, fr | (fq << 4)); ss += shx(ss, 32, fr | (fq << 4));
                if (fq == 0) sskv[row * 4 + wc] = ss;
            } else if (pn < 5) {
#pragma unroll
                for (int bj = 0; bj < 2; ++bj) { const f32x4 v0 = acc[ai][bj][m][0] * rs, v1 = acc[ai][bj][m][1] * rs;
                    const int ucol = (pn - 3) * 256 + bj * HALF + wc * 32 + fq * 8; const int g = ucol >> 4, h0 = ucol & 15;
                    *(u32x4*)(UP + (unsigned)(g * NCHR + (row >> 5)) * KS5 + (row & 31) * 16 + h0) = pack8(v0, v1); }
            } else {
#pragma unroll
                for (int bj = 0; bj < 2; ++bj) { const int gcol = (pn - 5) * 256 + bj * HALF + wc * 32 + fq * 8;
                    const f32x4 b0 = *(const f32x4*)(bgate + gcol), b1 = *(const f32x4*)(bgate + gcol + 4);
                    f32x4 v0 = acc[ai][bj][m][0] * rs + b0, v1 = acc[ai][bj][m][1] * rs + b1;
#pragma unroll
                    for (int j = 0; j < 4; ++j) { v0[j] = sigmoid_f(v0[j]); v1[j] = sigmoid_f(v1[j]); }
                    *(u32x4*)(GATES + (unsigned)row * 2048 + gcol) = pack8(v0, v1); }
            }
        EPI_ROWS_END
    }
};

struct EpiQ {
    static constexpr bool PERM = true, AFTER_DRAIN = false;
    const float* ssq; bf16_t* Q; const float* rope; float c2, epsv;
    __device__ __forceinline__ void operator()(const f32x4 (&acc)[2][2][4][2], const Unit& u, int wr, int wc, int fr, int fq) const {
        EPI_ROWS_BEGIN
            const f32x4 sa = *(const f32x4*)(ssq + row * 8), sb = *(const f32x4*)(ssq + row * 8 + 4);
            const float rs = rsqrtf((((sa[0] + sa[1]) + (sa[2] + sa[3])) + ((sb[0] + sb[1]) + (sb[2] + sb[3]))) * (1.0f / QL) + epsv) * c2;
#pragma unroll
            for (int bj = 0; bj < 2; ++bj) { f32x4 v0 = acc[ai][bj][m][0] * rs, v1 = acc[ai][bj][m][1] * rs;
                const int gi = u.pn * 8 + bj * 4 + wc;
                if (gi % 3 == 2) rope8(v0, v1, rope, row & (SEQ - 1), fq);
                *(u32x4*)(Q + (unsigned)row * 768 + u.pn * 256 + bj * HALF + wc * 32 + fq * 8) = pack8(v0, v1); }
        EPI_ROWS_END
    }
};
struct EpiKV {
    static constexpr bool PERM = true, AFTER_DRAIN = false;
    const float* sskv; bf16_t* KN; bf16_t* V; float epsv;
    __device__ __forceinline__ void operator()(const f32x4 (&acc)[2][2][4][2], const Unit& u, int wr, int wc, int fr, int fq) const {
        bf16_t* base = u.pn < 2 ? KN + u.pn * 256 : V + (u.pn - 2) * 256;
        EPI_ROWS_BEGIN
            const f32x4 sa = *(const f32x4*)(sskv + row * 4);
            const float rs = rsqrtf(((sa[0] + sa[1]) + (sa[2] + sa[3])) * (1.0f / KVL) + epsv);
#pragma unroll
            for (int bj = 0; bj < 2; ++bj) { const f32x4 v0 = acc[ai][bj][m][0] * rs, v1 = acc[ai][bj][m][1] * rs;
                *(u32x4*)(base + (unsigned)row * 512 + bj * HALF + wc * 32 + fq * 8) = pack8(v0, v1); }
        EPI_ROWS_END
    }
};
struct EpiState {
    static constexpr bool PERM = true, AFTER_DRAIN = false;
    float* SST;
    __device__ __forceinline__ void operator()(const f32x4 (&acc)[2][2][4][2], const Unit& u, int wr, int wc, int fr, int fq) const {
        EPI_ROWS_BEGIN
            float* p = SST + (unsigned)(u.z * NCHR + row) * 128u + wc * 32 + fq * 8;
            *(f32x4*)p = acc[ai][0][m][0]; *(f32x4*)(p + 4) = acc[ai][0][m][1];
        EPI_ROWS_END
    }
};
struct EpiS5 {
    static constexpr bool PERM = true, AFTER_DRAIN = false;
    bf16_t* Y;
    __device__ __forceinline__ void operator()(const f32x4 (&acc)[2][2][4][2], const Unit& u, int wr, int wc, int fr, int fq) const {
        EPI_ROWS_BEGIN
#pragma unroll
            for (int bj = 0; bj < 2; ++bj) { f32x4 v0 = acc[ai][bj][m][0], v1 = acc[ai][bj][m][1];
#pragma unroll
                for (int j = 0; j < 4; ++j) { v0[j] = gelu_tanh(v0[j]); v1[j] = gelu_tanh(v1[j]); }
                const int c = u.pn * 256 + bj * HALF + wc * 32 + fq * 8; const int t = c >> 4, h0 = c & 15;
                *(u32x4*)(Y + ((unsigned)row * LCH + t) * SSMW + u.z * 16 + h0) = pack8(v0, v1); }
        EPI_ROWS_END
    }
};
struct EpiOatt {
    static constexpr bool PERM = true, AFTER_DRAIN = false;
    const bf16_t* GATES; bf16_t* MERGED;
    __device__ __forceinline__ void operator()(const f32x4 (&acc)[2][2][4][2], const Unit& u, int wr, int wc, int fr, int fq) const {
        EPI_ROWS_BEGIN
#pragma unroll
            for (int bj = 0; bj < 2; ++bj) { const int col = u.pn * 256 + bj * HALF + wc * 32 + fq * 8;
                const u32x4 gw = *(const u32x4*)(GATES + (unsigned)row * 2048 + col);
                f32x4 v0 = acc[ai][bj][m][0], v1 = acc[ai][bj][m][1];
                v0[0] *= bf_lo(gw.x); v0[1] *= bf_hi(gw.x); v0[2] *= bf_lo(gw.y); v0[3] *= bf_hi(gw.y);
                v1[0] *= bf_lo(gw.z); v1[1] *= bf_hi(gw.z); v1[2] *= bf_lo(gw.w); v1[3] *= bf_hi(gw.w);
                *(u32x4*)(MERGED + (unsigned)row * DM + col) = pack8(v0, v1); }
        EPI_ROWS_END
    }
};
struct EpiGlu {
    static constexpr bool PERM = true, AFTER_DRAIN = false;
    const bf16_t* GATES; bf16_t* MERGED;
    __device__ __forceinline__ void operator()(const f32x4 (&acc)[2][2][4][2], const Unit& u, int wr, int wc, int fr, int fq) const {
        EPI_ROWS_BEGIN
#pragma unroll
            for (int bj = 0; bj < 2; ++bj) { const int col = u.pn * 128 + bj * 64 + wc * 16 + fq * 4;
                const u32x2 gw = *(const u32x2*)(GATES + (unsigned)row * 2048 + 1024 + col);
                bf16_t* mp = MERGED + (unsigned)row * DM + col; const u32x2 mw = *(const u32x2*)mp;
                const f32x4 ga = acc[ai][bj][m][0], gb = acc[ai][bj][m][1];
                const float r0 = bf_lo(mw.x) + bf_lo(gw.x) * ga[0] * sigmoid_f(gb[0]), r1 = bf_hi(mw.x) + bf_hi(gw.x) * ga[1] * sigmoid_f(gb[1]);
                const float r2 = bf_lo(mw.y) + bf_lo(gw.y) * ga[2] * sigmoid_f(gb[2]), r3 = bf_hi(mw.y) + bf_hi(gw.y) * ga[3] * sigmoid_f(gb[3]);
                u32x2 o; o.x = cvt_pk_bf16(r0, r1); o.y = cvt_pk_bf16(r2, r3); *(u32x2*)mp = o; }
        EPI_ROWS_END
    }
};
struct EpiYN {
    static constexpr bool PERM = true, AFTER_DRAIN = false;
    bf16_t* XB; float* OUT; const float* gvec; unsigned long long* gran; float* ssx; unsigned epoch; float epsv; LAS float* red;
    __device__ __forceinline__ void operator()(const f32x4 (&acc)[2][2][4][2], const Unit& u, int wr, int wc, int fr, int fq) const {
        const int lane = fr | (fq << 4);
        const unsigned coff = u.pn * 256 + wc * 32 + fq * 8; const unsigned row0 = u.pm * BM + wr * 64 + fr;
        u32x4 xw[4][2];
#pragma unroll
        for (int m = 0; m < 4; ++m)
#pragma unroll
            for (int bj = 0; bj < 2; ++bj) xw[m][bj] = *(const u32x4*)(XB + (row0 + m * 16) * DM + coff + bj * HALF);
        f32x4 g0[2], g1[2];
#pragma unroll
        for (int bj = 0; bj < 2; ++bj) { const float* gp = gvec + coff + bj * HALF; g0[bj] = *(const f32x4*)gp; g1[bj] = *(const f32x4*)(gp + 4); }
        EPI_ROWS_BEGIN
            float ss = 0.f;
#pragma unroll
            for (int bj = 0; bj < 2; ++bj) ss += sumsq8(acc[ai][bj][m][0], acc[ai][bj][m][1]);
            ss += shx(ss, 16, lane); ss += shx(ss, 32, lane);
            if (fq == 0) red[(row - u.pm * BM) * 4 + wc] = ss;
        EPI_ROWS_END
        asm volatile("s_waitcnt lgkmcnt(0)" ::: "memory"); __builtin_amdgcn_s_barrier(); asm volatile("" ::: "memory");
        if (wr == 0 && wc == 0) {
#pragma unroll
            for (int j = 0; j < 4; ++j) { const f32x4 q = *(const LAS f32x4*)(red + (4 * lane + j) * 4); const float t = (q[0] + q[1]) + (q[2] + q[3]);
                __hip_atomic_store(gran + (size_t)u.pn * T_TOK + u.pm * BM + 4 * lane + j, ((unsigned long long)epoch << 32) | (unsigned long long)__float_as_uint(t), __ATOMIC_RELAXED, __HIP_MEMORY_SCOPE_AGENT); }
        }
        unsigned long long gv[2][4];
        { unsigned sp = 0;
          for (;;) { bool ok = true;
#pragma unroll
              for (int ai = 0; ai < 2; ++ai)
#pragma unroll
                  for (int m = 0; m < 4; ++m) { gv[ai][m] = __hip_atomic_load(gran + (size_t)fq * T_TOK + row0 + ai * HALF + m * 16, __ATOMIC_RELAXED, __HIP_MEMORY_SCOPE_AGENT); ok = ok && ((unsigned)(gv[ai][m] >> 32) == epoch); }
              if (__all(ok) || ++sp > (1u << 20)) break;
              __builtin_amdgcn_s_sleep(1); } }
#pragma unroll
        for (int ai = 0; ai < 2; ++ai) {
            if (ai == 1) {
#pragma unroll
                for (int m = 0; m < 4; ++m)
#pragma unroll
                    for (int bj = 0; bj < 2; ++bj) xw[m][bj] = *(const u32x4*)(XB + (row0 + HALF + m * 16) * DM + coff + bj * HALF);
            }
#pragma unroll
            for (int m = 0; m < 4; ++m) { const unsigned row = row0 + ai * HALF + m * 16;
                float tot = __uint_as_float((unsigned)gv[ai][m]); tot += shx(tot, 16, lane); tot += shx(tot, 32, lane);
                const float rs = rsqrtf(tot * (1.0f / DM) + epsv);
                float ss = 0.f;
#pragma unroll
                for (int bj = 0; bj < 2; ++bj) { const unsigned off = row * DM + coff + bj * HALF; const u32x4 x4 = xw[m][bj];
                    f32x4 v0 = acc[ai][bj][m][0] * rs * g0[bj], v1 = acc[ai][bj][m][1] * rs * g1[bj];
                    v0[0] += bf_lo(x4.x); v0[1] += bf_hi(x4.x); v0[2] += bf_lo(x4.y); v0[3] += bf_hi(x4.y); v1[0] += bf_lo(x4.z); v1[1] += bf_hi(x4.z); v1[2] += bf_lo(x4.w); v1[3] += bf_hi(x4.w);
                    ss += sumsq8(v0, v1);
                    if (OUT) { *(f32x4*)(OUT + off) = v0; *(f32x4*)(OUT + off + 4) = v1; } else *(u32x4*)(XB + off) = pack8(v0, v1); }
                ss += shx(ss, 16, lane); ss += shx(ss, 32, lane);
                if (fq == 0) ssx[row * 16 + u.pn * 4 + wc] = ss; }
            asm volatile("" ::: "memory");
        }
    }
};
__device__ __forceinline__ void dpp_shr12(const f32x4 v, f32x4& r1, f32x4& r2) {
    float a0 = 0.f, a1 = 0.f, a2 = 0.f, a3 = 0.f, b0 = 0.f, b1 = 0.f, b2 = 0.f, b3 = 0.f; const float x0 = v[0], x1 = v[1], x2 = v[2], x3 = v[3];
    asm volatile("s_nop 1\n\t"
                 "v_mov_b32_dpp %0, %8 row_shr:1 row_mask:0xf bank_mask:0xf\n\t" "v_mov_b32_dpp %1, %9 row_shr:1 row_mask:0xf bank_mask:0xf\n\t"
                 "v_mov_b32_dpp %2, %10 row_shr:1 row_mask:0xf bank_mask:0xf\n\t" "v_mov_b32_dpp %3, %11 row_shr:1 row_mask:0xf bank_mask:0xf\n\t"
                 "v_mov_b32_dpp %4, %8 row_shr:2 row_mask:0xf bank_mask:0xf\n\t" "v_mov_b32_dpp %5, %9 row_shr:2 row_mask:0xf bank_mask:0xf\n\t"
                 "v_mov_b32_dpp %6, %10 row_shr:2 row_mask:0xf bank_mask:0xf\n\t" "v_mov_b32_dpp %7, %11 row_shr:2 row_mask:0xf bank_mask:0xf"
                 : "+v"(a0), "+v"(a1), "+v"(a2), "+v"(a3), "+v"(b0), "+v"(b1), "+v"(b2), "+v"(b3) : "v"(x0), "v"(x1), "v"(x2), "v"(x3));
    r1 = (f32x4){a0, a1, a2, a3}; r2 = (f32x4){b0, b1, b2, b3};
}
struct EpiUpConv {
    static constexpr bool PERM = true, AFTER_DRAIN = false;
    const float* ssx; float epsv; const float* cw; const float* cb; bf16_t* ACT; float* GL; float* GF; float* VF; LAS float* X;
    __device__ __forceinline__ void operator()(const f32x4 (&acc)[2][2][4][2], const Unit& u, int wr, int wc, int fr, int fq) const {
        const int lane = fr | (fq << 4);
        const unsigned oc0 = u.pn * 128 + wc * 16 + fq * 4;
        float rsv[2][4];
#pragma unroll
        for (int ai = 0; ai < 2; ++ai)
#pragma unroll
            for (int m = 0; m < 4; ++m) rsv[ai][m] = row_rstd(ssx, u.pm * BM + ai * HALF + wr * 64 + m * 16 + fr, epsv, lane, fq);
        if (fr >= 14) {
#pragma unroll
            for (int ai = 0; ai < 2; ++ai)
#pragma unroll
                for (int m = 0; m < 4; ++m) { const int gidx = ai * 8 + wr * 4 + m;
#pragma unroll
                    for (int bj = 0; bj < 2; ++bj) { const f32x4 cur = acc[ai][bj][m][0] * rsv[ai][m];
                        *(LAS f32x4*)(X + ((((gidx * 4 + wc) * 2 + bj) * 2 + (fr - 14)) * 4 + fq) * 4) = cur;
                        if (gidx == 15) *(f32x4*)(GL + (size_t)(u.pm * 2 + (fr - 14)) * DFF + oc0 + bj * 64) = cur; } }
        }
        f32x4 w0[2], w1[2], w2[2], bb[2];
#pragma unroll
        for (int bj = 0; bj < 2; ++bj) { const unsigned oc = oc0 + bj * 64; w0[bj] = *(const f32x4*)(cw + oc); w1[bj] = *(const f32x4*)(cw + DFF + oc); w2[bj] = *(const f32x4*)(cw + 2 * DFF + oc); bb[bj] = *(const f32x4*)(cb + oc); }
        asm volatile("s_waitcnt lgkmcnt(0)" ::: "memory"); __builtin_amdgcn_s_barrier(); asm volatile("" ::: "memory");
#pragma unroll
        for (int ai = 0; ai < 2; ++ai)
#pragma unroll
            for (int m = 0; m < 4; ++m) { const int gidx = ai * 8 + wr * 4 + m; const unsigned row = u.pm * BM + ai * HALF + wr * 64 + m * 16 + fr; const float rs = rsv[ai][m];
#pragma unroll
                for (int bj = 0; bj < 2; ++bj) { const unsigned oc = oc0 + bj * 64;
                    const f32x4 cur = acc[ai][bj][m][0] * rs, val = acc[ai][bj][m][1] * rs;
                    f32x4 g1, g2; dpp_shr12(cur, g1, g2);
                    if (fr < 2) {
                        f32x4 x14 = {0.f, 0.f, 0.f, 0.f}, x15 = x14;
                        if (gidx > 0) { const LAS float* xp = X + (((((gidx - 1) * 4 + wc) * 2 + bj) * 2) * 4 + fq) * 4; x14 = *(const LAS f32x4*)xp; x15 = *(const LAS f32x4*)(xp + 16); }
                        if (fr == 0) { g1 = x15; g2 = x14; } else g2 = x15;
                        if (gidx == 0) { *(f32x4*)(GF + (size_t)(u.pm * 2 + fr) * DFF + oc) = cur; *(f32x4*)(VF + (size_t)(u.pm * 2 + fr) * DFF + oc) = val; }
                    }
                    const f32x4 cv = bb[bj] + w0[bj] * g2 + w1[bj] * g1 + w2[bj] * cur;
                    f32x4 o;
#pragma unroll
                    for (int j = 0; j < 4; ++j) o[j] = gelu_tanh(cv[j]) * val[j];
                    u32x2 w; w.x = cvt_pk_bf16(o[0], o[1]); w.y = cvt_pk_bf16(o[2], o[3]);
                    *(u32x2*)(ACT + row * DFF + oc) = w; }
            }
    }
};

struct Args { const float* in[26]; float* out; unsigned char* ws; int ph_lo, ph_hi; };
struct Ctx { unsigned char* ws; const long long* dl; float* out;
    __device__ __forceinline__ const float* inp(int i) const { return (const float*)(ws + dl[i]); } };

enum { I_X = 0, I_WIN, I_BGATE, I_GMIXPRE, I_GQ, I_WUQ, I_GKV, I_WUKV, I_WOATT, I_LAMRE, I_LAMIM, I_LOGSTEP, I_BRE, I_BIM, I_CRE, I_CIM, I_DSKIP, I_WGLU, I_WOUT, I_GMIXPOST, I_GFFNPRE, I_WUP, I_CONVW, I_CONVB, I_WDOWN, I_GFFNPOST };

__device__ __forceinline__ float wave_sum(float v, int lane) {
#pragma unroll
    for (int o = 1; o < 64; o <<= 1) v += shx(v, o, lane);
    return v;
}

__device__ __forceinline__ int rope_sigma(int c) { return 4 * (c >> 3) + (c & 3) + 16 * ((c >> 2) & 1); }
__device__ __forceinline__ int src_col(int kind, int n) {
    if (kind == 0) {
        if (n < 384) return n;
        if (n < 416) return 640 + rope_sigma(n - 384);
        if (n < 512) return -1;
        if (n < 768) return 384 + (n - 512);
        if (n < 1280) return 672 + (n - 768);
        return 1184 + (n - 1280);
    } else if (kind == 1) {
        const int h = n / 96, c = n % 96; return c < 64 ? n : h * 96 + 64 + rope_sigma(c - 64);
    } else if (kind == 2) {
        const int hh = (n & 511) >> 6, d = n & 63; return hh * 128 + (n >= 512 ? 64 : 0) + d;
    } else if (kind == 3) {
        const int q = n >> 3, nn = (n >> 2) & 1, j = n & 3; return nn * 1024 + 4 * q + j;
    } else if (kind == 5) {
        const int q = n >> 3, nn = (n >> 2) & 1, j = n & 3; return nn * DFF + 4 * q + j;
    }
    return n;
}
__device__ __forceinline__ void transpose_item(int kind, const float* W, int K, int Nsrc, bf16_t* WT, const float* gk, LAS float* scr, int item, int nblk, int lane) {
    const int kb = item / nblk, nb = item % nblk, k0 = 64 * kb, n0 = 32 * nb;
    const int src = src_col(kind, n0 + (lane & 31));
    float v[32];
    const float* wp = W + (size_t)(k0 + (lane >> 5)) * Nsrc + (src >= 0 ? src : 0);
#pragma unroll
    for (int i = 0; i < 32; ++i) v[i] = wp[(size_t)(2 * i) * Nsrc];
    if (src < 0) {
#pragma unroll
        for (int i = 0; i < 32; ++i) v[i] = 0.f;
    }
    if (gk) {
#pragma unroll
        for (int i = 0; i < 32; ++i) v[i] *= gk[k0 + 2 * i + (lane >> 5)];
    }
#pragma unroll
    for (int i = 0; i < 32; ++i) scr[(2 * i + (lane >> 5)) * 33 + (lane & 31)] = v[i];
    asm volatile("s_waitcnt lgkmcnt(0)" ::: "memory");
    const int c = lane & 7;
#pragma unroll
    for (int j = 0; j < 4; ++j) { const int n = (lane >> 3) + 8 * j; const LAS float* s = scr + (8 * c) * 33 + n;
        u32x4 o; o.x = cvt_pk_bf16(s[0 * 33], s[1 * 33]); o.y = cvt_pk_bf16(s[2 * 33], s[3 * 33]); o.z = cvt_pk_bf16(s[4 * 33], s[5 * 33]); o.w = cvt_pk_bf16(s[6 * 33], s[7 * 33]);
        *(u32x4*)(WT + (size_t)(n0 + n) * K + k0 + 8 * c) = o; }
    asm volatile("s_waitcnt lgkmcnt(0)" ::: "memory");
}

__device__ __forceinline__ void sincos_red(float x, float& sn, float& cs) {
    const float k = rintf(x * 0.15915494309189535f);
    float r = fmaf(-k, 6.28125f, x); r = fmaf(-k, 1.9353071795864769e-3f, r);
    sn = __sinf(r); cs = __cosf(r);
}
__device__ __forceinline__ void s5_prep_item(const Ctx& a, int l, int g, int qt, LAS unsigned char* lds, int tid) {
    constexpr int PS = 65;
    LAS float* pr = (LAS float*)lds; LAS float* pi = pr + 2176; LAS float* bbr = pi + 2176; LAS float* bbi = bbr + 1024;
    LAS float* crT = bbi + 1024; LAS float* ciT = crT + 1024; LAS float* Kt = ciT + 1024; LAS float* frv = Kt + 8192; LAS float* fiv = frv + 64;
    const int lg = l * NGRP + g;
    const float delta = __expf(a.inp(I_LOGSTEP)[lg]);
    for (int idx = tid; idx < 33 * 64; idx += 512) { const int tau = idx >> 6, p = idx & 63;
        const float lr = a.inp(I_LAMRE)[lg * 64 + p], li = a.inp(I_LAMIM)[lg * 64 + p];
        const float mag = __expf(lr * delta * (float)tau);
        float sn, cs; sincos_red(li * delta * (float)tau, sn, cs);
        pr[tau * PS + p] = mag * cs; pi[tau * PS + p] = mag * sn; }
    for (int idx = tid; idx < 1024; idx += 512) { const int h = idx >> 6, p = idx & 63; crT[p * 16 + h] = a.inp(I_CRE)[(size_t)lg * 1024 + idx]; ciT[p * 16 + h] = a.inp(I_CIM)[(size_t)lg * 1024 + idx]; }
    if (tid < 64) { const int p = tid;
        const float lr = a.inp(I_LAMRE)[lg * 64 + p], li = a.inp(I_LAMIM)[lg * 64 + p];
        const float xe = lr * delta; const float em = xe * (1.0f + xe * (0.5f + xe * (0.16666667f + xe * (0.041666668f + xe * 0.0083333338f))));
        float sn, cs, sh, ch; sincos_red(li * delta, sn, cs); sincos_red(0.5f * li * delta, sh, ch);
        const float nr = em * cs - 2.0f * sh * sh, ni = (1.0f + em) * sn, den = lr * lr + li * li;
        frv[p] = (nr * lr + ni * li) / den; fiv[p] = (ni * lr - nr * li) / den; }
    __syncthreads();
    if (qt == 0 && tid < 64) { float* AL = (float*)(a.ws + OFF_AL); AL[(g * 64 + tid) * 2] = pr[32 * PS + tid]; AL[(g * 64 + tid) * 2 + 1] = pi[32 * PS + tid]; }
    for (int idx = tid; idx < 1024; idx += 512) { const int p = idx >> 4;
        const float br = a.inp(I_BRE)[(size_t)lg * 1024 + idx], bi = a.inp(I_BIM)[(size_t)lg * 1024 + idx];
        bbr[idx] = frv[p] * br - fiv[p] * bi; bbi[idx] = frv[p] * bi + fiv[p] * br; }
    __syncthreads();
    {
        const int tau = tid >> 4, h = tid & 15;
        f32x4 s0 = {0.f, 0.f, 0.f, 0.f}, s1 = s0, s2 = s0, s3 = s0;
        for (int p = 0; p < 64; ++p) { const float c_r = crT[p * 16 + h], c_i = ciT[p * 16 + h], a_r = pr[tau * PS + p], a_i = pi[tau * PS + p];
            const float car = c_r * a_r - c_i * a_i, cai = c_r * a_i + c_i * a_r;
            const LAS f32x4* br4 = (const LAS f32x4*)(bbr + p * 16); const LAS f32x4* bi4 = (const LAS f32x4*)(bbi + p * 16);
            s0 += car * br4[0] - cai * bi4[0]; s1 += car * br4[1] - cai * bi4[1]; s2 += car * br4[2] - cai * bi4[2]; s3 += car * br4[3] - cai * bi4[3]; }
        if (tau == 0) { const float dd = a.inp(I_DSKIP)[l * SSMW + g * 16 + h];
            if ((h >> 2) == 0) s0[h & 3] += dd; else if ((h >> 2) == 1) s1[h & 3] += dd; else if ((h >> 2) == 2) s2[h & 3] += dd; else s3[h & 3] += dd; }
        LAS f32x4* kp = (LAS f32x4*)(Kt + tau * 256 + h * 16); kp[0] = s0; kp[1] = s1; kp[2] = s2; kp[3] = s3;
    }
    __syncthreads();
    bf16_t* TVg = (bf16_t*)(a.ws + WS_W) + WE_TV + (size_t)g * 512 * KS5;
    for (int it = tid; it < 128 * 80; it += 512) { const int n = 128 * qt + it / 80, kc = it % 80, t = n >> 4, h = n & 15; float v[8];
        if (kc < 64) { const int s = kc >> 1, hp0 = (kc & 1) * 8;
#pragma unroll
            for (int j = 0; j < 8; ++j) v[j] = (s <= t) ? Kt[((t - s) & 31) * 256 + h * 16 + hp0 + j] : 0.f;
        } else if (kc < 72) { const int p0 = (kc - 64) * 8;
#pragma unroll
            for (int j = 0; j < 8; ++j) { const int p = p0 + j; v[j] = crT[p * 16 + h] * pr[(t + 1) * PS + p] - ciT[p * 16 + h] * pi[(t + 1) * PS + p]; }
        } else { const int p0 = (kc - 72) * 8;
#pragma unroll
            for (int j = 0; j < 8; ++j) { const int p = p0 + j; v[j] = -(crT[p * 16 + h] * pi[(t + 1) * PS + p] + ciT[p * 16 + h] * pr[(t + 1) * PS + p]); }
        }
        u32x4 o; o.x = cvt_pk_bf16(v[0], v[1]); o.y = cvt_pk_bf16(v[2], v[3]); o.z = cvt_pk_bf16(v[4], v[5]); o.w = cvt_pk_bf16(v[6], v[7]);
        *(u32x4*)(TVg + (size_t)n * KS5 + kc * 8) = o; }
    bf16_t* Wg = (bf16_t*)(a.ws + WS_W) + WE_WST + (size_t)g * 256 * 512;
    for (int it = tid; it < 64 * 64; it += 512) { const int n = 64 * qt + (it >> 6), kc = it & 63, s = kc >> 1, hp0 = (kc & 1) * 8, tau = 31 - s; float v[8];
        if (n < 64) { const int p = n;
#pragma unroll
            for (int j = 0; j < 8; ++j) v[j] = pr[tau * PS + p] * bbr[p * 16 + hp0 + j] - pi[tau * PS + p] * bbi[p * 16 + hp0 + j];
        } else if (n < 128) { const int p = n - 64;
#pragma unroll
            for (int j = 0; j < 8; ++j) v[j] = pr[tau * PS + p] * bbi[p * 16 + hp0 + j] + pi[tau * PS + p] * bbr[p * 16 + hp0 + j];
        } else {
#pragma unroll
            for (int j = 0; j < 8; ++j) v[j] = 0.f;
        }
        u32x4 o; o.x = cvt_pk_bf16(v[0], v[1]); o.y = cvt_pk_bf16(v[2], v[3]); o.z = cvt_pk_bf16(v[4], v[5]); o.w = cvt_pk_bf16(v[6], v[7]);
        *(u32x4*)(Wg + (size_t)n * 512 + kc * 8) = o; }
    __syncthreads();
}

__device__ __forceinline__ void prep_layer(const Ctx& a, int l, LAS unsigned char* lds, int tid, int wid, int lane, int G, int cu, int part) {
    if (part == 0) for (int it = cu; it < NGRP * 4; it += G) s5_prep_item(a, l, it >> 2, it & 3, lds, tid);
    __syncthreads();
    LAS float* scr = (LAS float*)(lds + wid * 16384);
    bf16_t* Wb = (bf16_t*)(a.ws + WS_W);
    constexpr int N_IN = 16 * 104, N_UQ = 6 * 24, N_UKV = 4 * 32, N_OATT = 8 * 32, N_GLU = 8 * 64, N_OUT = 16 * 32, N_UP = 16 * 176, N_DOWN = 44 * 32;
    constexpr int NITEMS = N_IN + N_UQ + N_UKV + N_OATT + N_GLU + N_OUT + N_UP + N_DOWN;
    constexpr int N_MIX = N_IN + N_UQ + N_UKV + N_OATT + N_GLU + N_OUT;
    const int gw = part == 0 ? ((cu + G / 2) % G) * 8 + wid : N_MIX + (cu - G / 2) * 8 + wid;
    const int NGW = part == 0 ? G * 8 : (G - G / 2) * 8, iend = part == 0 ? N_MIX : NITEMS;
    for (int it = gw; it < iend; it += NGW) { int r = it, kind, si, gi, K, Nsrc, nblk; size_t lstride, doff;
        if (r < N_IN) { kind = 0; si = I_WIN; gi = I_GMIXPRE; K = DM; Nsrc = INC; nblk = 104; lstride = (size_t)DM * INC; doff = WE_IN; }
        else if ((r -= N_IN) < N_UQ) { kind = 1; si = I_WUQ; gi = I_GQ; K = QL; Nsrc = 768; nblk = 24; lstride = (size_t)QL * 768; doff = WE_UQ; }
        else if ((r -= N_UQ) < N_UKV) { kind = 2; si = I_WUKV; gi = I_GKV; K = KVL; Nsrc = 1024; nblk = 32; lstride = (size_t)KVL * 1024; doff = WE_UKV; }
        else if ((r -= N_UKV) < N_OATT) { kind = 4; si = I_WOATT; gi = -1; K = 512; Nsrc = DM; nblk = 32; lstride = (size_t)512 * DM; doff = WE_OATT; }
        else if ((r -= N_OATT) < N_GLU) { kind = 3; si = I_WGLU; gi = -1; K = SSMW; Nsrc = 2048; nblk = 64; lstride = (size_t)SSMW * 2048; doff = WE_GLU; }
        else if ((r -= N_GLU) < N_OUT) { kind = 4; si = I_WOUT; gi = -1; K = DM; Nsrc = DM; nblk = 32; lstride = (size_t)DM * DM; doff = WE_OUT; }
        else if ((r -= N_OUT) < N_UP) { kind = 5; si = I_WUP; gi = I_GFFNPRE; K = DM; Nsrc = 2 * DFF; nblk = 176; lstride = (size_t)DM * 2 * DFF; doff = WE_UP; }
        else { r -= N_UP; kind = 4; si = I_WDOWN; gi = -1; K = DFF; Nsrc = DM; nblk = 32; lstride = (size_t)DFF * DM; doff = WE_DOWN; }
        const float* W = a.inp(si) + (size_t)l * lstride; const float* gk = gi >= 0 ? a.inp(gi) + (size_t)l * K : nullptr;
        transpose_item(kind, W, K, Nsrc, Wb + doff, gk, scr, r, nblk, lane);
    }
    __syncthreads();
}

__device__ __forceinline__ void init_phase(const Ctx& a, int tid, int wid, int lane, int G, int cu, float epsv) {
    const int gw = cu * 8 + wid, NGW = G * 8;
    bf16_t* XB = (bf16_t*)(a.ws + WS_XY); float* ssx = (float*)(a.ws + WS_SSX);
    for (int row = gw; row < T_TOK; row += NGW) {
        const f32x4* xr = (const f32x4*)(a.inp(I_X) + (size_t)row * DM) + lane; u32x2* bo = (u32x2*)(XB + (size_t)row * DM) + lane;
        float ss = 0.f;
#pragma unroll
        for (int j = 0; j < 4; ++j) { const f32x4 v = xr[64 * j]; ss += (v[0] * v[0] + v[1] * v[1]) + (v[2] * v[2] + v[3] * v[3]);
            u32x2 w; w.x = cvt_pk_bf16(v[0], v[1]); w.y = cvt_pk_bf16(v[2], v[3]); bo[64 * j] = w; }
        ss = wave_sum(ss, lane);
        if (lane < 16) ssx[row * 16 + lane] = lane == 0 ? ss : 0.f;
    }
    const int gt = cu * 512 + tid, NT = G * 512;
    float* rope = (float*)(a.ws + OFF_ROPE);
    for (int i = gt; i < SEQ * 16; i += NT) { const int pos = i >> 4, k = i & 15;
        const float inv = exp2f(-(float)k * 0.83048202372184058696f);
        float sn, cs; sincos_red((float)pos * inv, sn, cs);
        rope[2 * i] = cs; rope[2 * i + 1] = sn; }
}

__device__ __forceinline__ void normres_phase(const Ctx& a, const float* gvec, const float* ssy, int tid, int wid, int lane, int G, int cu, float epsv, bool final_out) {
    const int gw = cu * 8 + wid, NGW = G * 8;
    float* X = a.out; bf16_t* XB = (bf16_t*)(a.ws + WS_XY); const bf16_t* YB = (const bf16_t*)(a.ws + WS_YB); float* rstdx = (float*)(a.ws + OFF_RSTDX);
    f32x4 gv[4];
#pragma unroll
    for (int j = 0; j < 4; ++j) gv[j] = ((const f32x4*)gvec)[lane + 64 * j];
    for (int row0 = gw * 4; row0 < T_TOK; row0 += NGW * 4) {
        u32x2 xw[4][4], yw[4][4]; float rs[4];
#pragma unroll
        for (int r = 0; r < 4; ++r) { const int row = row0 + r;
            const u32x2* xp = (const u32x2*)(XB + (size_t)row * DM) + lane; const u32x2* yp = (const u32x2*)(YB + (size_t)row * DM) + lane;
#pragma unroll
            for (int j = 0; j < 4; ++j) { xw[r][j] = xp[64 * j]; yw[r][j] = yp[64 * j]; }
            rs[r] = ssy[row * 16 + (lane & 15)]; }
#pragma unroll
        for (int r = 0; r < 4; ++r) { const int row = row0 + r;
            float sp_ = rs[r];
            sp_ += shx(sp_, 1, lane); sp_ += shx(sp_, 2, lane); sp_ += shx(sp_, 4, lane); sp_ += shx(sp_, 8, lane);
            const float rsv = rsqrtf(sp_ * (1.0f / DM) + epsv);
            u32x2* xp = (u32x2*)(XB + (size_t)row * DM) + lane; f32x4* op = (f32x4*)(X + (size_t)row * DM) + lane;
            float ss = 0.f;
#pragma unroll
            for (int j = 0; j < 4; ++j) { const u32x2 x2 = xw[r][j], y2 = yw[r][j]; f32x4 v;
                v[0] = bf_lo(x2.x) + bf_lo(y2.x) * rsv * gv[j][0]; v[1] = bf_hi(x2.x) + bf_hi(y2.x) * rsv * gv[j][1]; v[2] = bf_lo(x2.y) + bf_lo(y2.y) * rsv * gv[j][2]; v[3] = bf_hi(x2.y) + bf_hi(y2.y) * rsv * gv[j][3];
                ss += (v[0] * v[0] + v[1] * v[1]) + (v[2] * v[2] + v[3] * v[3]);
                if (final_out) op[64 * j] = v;
                else { u32x2 w; w.x = cvt_pk_bf16(v[0], v[1]); w.y = cvt_pk_bf16(v[2], v[3]); xp[64 * j] = w; } }
            ss = wave_sum(ss, lane);
            if (lane == 0) rstdx[row] = rsqrtf(ss * (1.0f / DM) + epsv);
        }
    }
}

__device__ __forceinline__ void conv_fixup_phase(const Ctx& a, int l, int tid, int G, int cu) {
    const int gt = cu * 512 + tid, NT = G * 512;
    const float* GL = (const float*)(a.ws + WS_GL); const float* GF = (const float*)(a.ws + WS_GF); const float* VF = (const float*)(a.ws + WS_VF); bf16_t* ACT = (bf16_t*)(a.ws + WS_VAL);
    const float* cw = a.inp(I_CONVW) + (size_t)l * 3 * DFF; const float* cb = a.inp(I_CONVB) + (size_t)l * DFF;
    constexpr int NC4 = DFF / 4;
    for (int it = gt; it < (T_TOK / BM) * NC4; it += NT) { const int pm = it / NC4, oc = (it - pm * NC4) * 4;
        const f32x4 z = {0.f, 0.f, 0.f, 0.f};
        const bool first = (pm & (SEQ / BM - 1)) == 0;
        const f32x4 p14 = first ? z : *(const f32x4*)(GL + (size_t)((pm - 1) * 2 + 0) * DFF + oc), p15 = first ? z : *(const f32x4*)(GL + (size_t)((pm - 1) * 2 + 1) * DFF + oc);
        const f32x4 c0 = *(const f32x4*)(GF + (size_t)(pm * 2 + 0) * DFF + oc), c1 = *(const f32x4*)(GF + (size_t)(pm * 2 + 1) * DFF + oc);
        const f32x4 v0 = *(const f32x4*)(VF + (size_t)(pm * 2 + 0) * DFF + oc), v1 = *(const f32x4*)(VF + (size_t)(pm * 2 + 1) * DFF + oc);
        const f32x4 w0 = *(const f32x4*)(cw + oc), w1 = *(const f32x4*)(cw + DFF + oc), w2 = *(const f32x4*)(cw + 2 * DFF + oc), bb = *(const f32x4*)(cb + oc);
        const f32x4 cv0 = bb + w0 * p14 + w1 * p15 + w2 * c0, cv1 = bb + w0 * p15 + w1 * c0 + w2 * c1;
        f32x4 o0, o1;
#pragma unroll
        for (int j = 0; j < 4; ++j) { o0[j] = gelu_tanh(cv0[j]) * v0[j]; o1[j] = gelu_tanh(cv1[j]) * v1[j]; }
        u32x2 w; w.x = cvt_pk_bf16(o0[0], o0[1]); w.y = cvt_pk_bf16(o0[2], o0[3]); *(u32x2*)(ACT + (size_t)(pm * BM) * DFF + oc) = w;
        w.x = cvt_pk_bf16(o1[0], o1[1]); w.y = cvt_pk_bf16(o1[2], o1[3]); *(u32x2*)(ACT + (size_t)(pm * BM + 1) * DFF + oc) = w;
    }
}

__device__ __forceinline__ void carry_phase(const Ctx& a, int tid, int G, int cu) {
    const float* AL = (const float*)(a.ws + OFF_AL); const float* SST = (const float*)(a.ws + WS_SST); bf16_t* UP = (bf16_t*)(a.ws + WS_UP);
    if (tid < 128)
    for (int idx = cu * 128 + tid; idx < NBATCH * NGRP * NST; idx += G * 128) { const int p = idx & 63, g = (idx >> 6) & 31, b = idx >> 11;
        const float alr = AL[(g * 64 + p) * 2], ali = AL[(g * 64 + p) * 2 + 1]; float sr = 0.f, si = 0.f;
        const size_t R0 = (size_t)g * NCHR + b * (SEQ / LCH);
#pragma unroll
        for (int h = 0; h < 2; ++h) {
            float xr[32], xi[32];
#pragma unroll
            for (int c = 0; c < 32; ++c) { xr[c] = SST[(R0 + h * 32 + c) * 128 + p]; xi[c] = SST[(R0 + h * 32 + c) * 128 + 64 + p]; }
#pragma unroll
            for (int c = 0; c < 32; ++c) { const size_t R = R0 + h * 32 + c;
                UP[R * KS5 + 512 + p] = (bf16_t)(cvt_pk_bf16(sr, 0.f) & 0xffffu); UP[R * KS5 + 576 + p] = (bf16_t)(cvt_pk_bf16(si, 0.f) & 0xffffu);
                const float nr = alr * sr - ali * si + xr[c], ni = alr * si + ali * sr + xi[c]; sr = nr; si = ni; }
        }
    }
}

typedef __attribute__((address_space(3))) const char* lds_cptr;
typedef short v4i16_t __attribute__((ext_vector_type(4)));
__device__ __forceinline__ s16x4 vtr(lds_cptr p) { return __builtin_bit_cast(s16x4, __builtin_amdgcn_ds_read_tr16_b64_v4i16((__attribute__((address_space(3))) v4i16_t*)p)); }

__device__ __forceinline__ float quad_max(float x) {
    float p = x, q = x; asm volatile("s_nop 1\n\tv_permlane32_swap_b32 %0, %1" : "+v"(p), "+v"(q));
    float m = fmaxf(p, q); p = m; q = m; asm volatile("s_nop 1\n\tv_permlane16_swap_b32 %0, %1" : "+v"(p), "+v"(q));
    return fmaxf(p, q);
}
__device__ __forceinline__ float quad_sum(float x) {
    float p = x, q = x; asm volatile("s_nop 1\n\tv_permlane32_swap_b32 %0, %1" : "+v"(p), "+v"(q));
    float m = p + q; p = m; q = m; asm volatile("s_nop 1\n\tv_permlane16_swap_b32 %0, %1" : "+v"(p), "+v"(q));
    return p + q;
}
__device__ __forceinline__ void attn_tile(LAS unsigned char* Kb, LAS unsigned char* Vb, const bf16x8 (&qf)[2][3], f32x4 (&o)[4][2], float (&mrun)[2], float (&lrun)[2], int l15, int quad, int lane) {
            f32x4 s[4][2];
            bf16x8 kf[4][3];
#pragma unroll
            for (int kb = 0; kb < 4; ++kb)
#pragma unroll
                for (int dc = 0; dc < 3; ++dc) kf[kb][dc] = *(const LAS bf16x8*)(Kb + (kb * 16 + l15) * 256 + (((dc * 4 + quad) ^ l15) << 4));
            __builtin_amdgcn_sched_barrier(0);
#pragma unroll
            for (int kb = 0; kb < 4; ++kb) {
#pragma unroll
                for (int dc = 0; dc < 3; ++dc) {
#pragma unroll
                    for (int qk = 0; qk < 2; ++qk) s[kb][qk] = __builtin_amdgcn_mfma_f32_16x16x32_bf16(kf[kb][dc], qf[qk][dc], dc == 0 ? (f32x4){0.f, 0.f, 0.f, 0.f} : s[kb][qk], 0, 0, 0); }
            }
            s16x4 vlo[2][4], vhi[2][4];
#pragma unroll
            for (int kk = 0; kk < 2; ++kk)
#pragma unroll
                for (int d = 0; d < 4; ++d) { const lds_cptr vp = (lds_cptr)(Vb + (32 * kk + 4 * quad + (l15 >> 2)) * 160 + (16 * d + 4 * (lane & 3)) * 2); vlo[kk][d] = vtr(vp); vhi[kk][d] = vtr(vp + 16 * 160); }
            __builtin_amdgcn_sched_barrier(0);
            float mx2[2];
#pragma unroll
            for (int qk = 0; qk < 2; ++qk) {
                float mx = s[0][qk][0];
#pragma unroll
                for (int kb = 0; kb < 4; ++kb)
#pragma unroll
                    for (int j = 0; j < 4; ++j) mx = fmaxf(mx, s[kb][qk][j]);
                mx2[qk] = quad_max(mx); }
            if (!__all((mx2[0] - mrun[0] <= 8.0f) && (mx2[1] - mrun[1] <= 8.0f))) {
#pragma unroll
                for (int qk = 0; qk < 2; ++qk) { const float mn = fmaxf(mrun[qk], mx2[qk]), alpha = __builtin_amdgcn_exp2f(mrun[qk] - mn); mrun[qk] = mn; lrun[qk] *= alpha;
#pragma unroll
                    for (int d = 0; d < 4; ++d) o[d][qk] = o[d][qk] * alpha; }
            }
#pragma unroll
            for (int qk = 0; qk < 2; ++qk) { const float mn = mrun[qk]; float rsum = 0.f;
#pragma unroll
                for (int kb = 0; kb < 4; ++kb)
#pragma unroll
                    for (int j = 0; j < 4; ++j) { const float p = __builtin_amdgcn_exp2f(s[kb][qk][j] - mn); rsum += p; s[kb][qk][j] = p; }
                lrun[qk] += rsum; }
#pragma unroll
            for (int kk = 0; kk < 2; ++kk) {
                bf16x8 pf[2];
#pragma unroll
                for (int qk = 0; qk < 2; ++qk) { const u32x4 w = pack8(s[2 * kk][qk], s[2 * kk + 1][qk]); pf[qk] = __builtin_bit_cast(bf16x8, w); }
#pragma unroll
                for (int d = 0; d < 4; ++d) {
                    const s16x4 lo = vlo[kk][d], hi = vhi[kk][d];
                    const bf16x8 vf = (bf16x8){lo[0], lo[1], lo[2], lo[3], hi[0], hi[1], hi[2], hi[3]};
#pragma unroll
                    for (int qk = 0; qk < 2; ++qk) o[d][qk] = __builtin_amdgcn_mfma_f32_16x16x32_bf16(vf, pf[qk], o[d][qk], 0, 0, 0);
                }
            }
}
__device__ __forceinline__ void attn_unit(const Ctx& a, LAS unsigned char* lds, int b, int h, int qb, int tid, int wid, int lane) {
    const bf16_t* Q = (const bf16_t*)(a.ws + WS_Q); const bf16_t* KN = (const bf16_t*)(a.ws + WS_KN); const bf16_t* KPE = (const bf16_t*)(a.ws + WS_KPE);
    const bf16_t* V = (const bf16_t*)(a.ws + WS_V); bf16_t* O = (bf16_t*)(a.ws + WS_O);
    const int l15 = lane & 15, quad = lane >> 4;
    const int ntile = 4 * qb + 4, cw = 4 * qb + (wid >> 1);
    const size_t tok0 = (size_t)b * SEQ;
    bf16x8 qf[2][3];
#pragma unroll
    for (int qk = 0; qk < 2; ++qk)
#pragma unroll
        for (int dc = 0; dc < 3; ++dc) qf[qk][dc] = *(const bf16x8*)(Q + (tok0 + qb * 256 + wid * 32 + qk * 16 + l15) * 768 + h * QKD + dc * 32 + quad * 8);
    f32x4 o[4][2];
#pragma unroll
    for (int d = 0; d < 4; ++d) { o[d][0] = (f32x4){0.f, 0.f, 0.f, 0.f}; o[d][1] = (f32x4){0.f, 0.f, 0.f, 0.f}; }
    float mrun[2] = {-INFINITY, -INFINITY}, lrun[2] = {0.f, 0.f};
    const int kkey = tid >> 3, kch = tid & 7;
    const int pkey = (tid >> 2) & 63, pch = 8 + (tid & 3);
    const unsigned k_lds = kkey * 256 + ((kch ^ (kkey & 15)) << 4), p_lds = pkey * 256 + ((pch ^ (pkey & 15)) << 4), v_lds = kkey * 160 + kch * 16;
    const bf16_t* gk = KN + (tok0 + kkey) * 512 + h * 64 + kch * 8; const bf16_t* gp = KPE + (tok0 + pkey) * ROPE_D + (tid & 3) * 8; const bf16_t* gv = V + (tok0 + kkey) * 512 + h * 64 + kch * 8;
    const bool ppe = tid < 256;
    u32x4 r0k = *(const u32x4*)gk, r0v = *(const u32x4*)gv, r0p = (u32x4){0u, 0u, 0u, 0u};
    if (ppe) r0p = *(const u32x4*)gp;
    u32x4 r1k = *(const u32x4*)(gk + (size_t)64 * 512), r1v = *(const u32x4*)(gv + (size_t)64 * 512), r1p = (u32x4){0u, 0u, 0u, 0u};
    if (ppe) r1p = *(const u32x4*)(gp + (size_t)64 * ROPE_D);
    *(LAS u32x4*)(lds + k_lds) = r0k; *(LAS u32x4*)(lds + 32768 + v_lds) = r0v; if (ppe) *(LAS u32x4*)(lds + p_lds) = r0p;
    __syncthreads();
#define ATT_STEP(KT, RAk, RAv, RAp, RBk, RBv, RBp) { const int kt_ = (KT); \
        if (kt_ + 2 < ntile) { const size_t adv = (size_t)(kt_ + 2) * 64; RAk = *(const u32x4*)(gk + adv * 512); RAv = *(const u32x4*)(gv + adv * 512); if (ppe) RAp = *(const u32x4*)(gp + adv * ROPE_D); } \
        if (kt_ <= cw) attn_tile(lds + (kt_ & 1) * 16384, lds + 32768 + (kt_ & 1) * 10240, qf, o, mrun, lrun, l15, quad, lane); \
        if (kt_ + 1 < ntile) { const int nb = (kt_ + 1) & 1; \
            *(LAS u32x4*)(lds + nb * 16384 + k_lds) = RBk; *(LAS u32x4*)(lds + 32768 + nb * 10240 + v_lds) = RBv; if (ppe) *(LAS u32x4*)(lds + nb * 16384 + p_lds) = RBp; } \
        __syncthreads(); }
    for (int kt = 0; kt < ntile; kt += 2) {
        ATT_STEP(kt, r0k, r0v, r0p, r1k, r1v, r1p)
        ATT_STEP(kt + 1, r1k, r1v, r1p, r0k, r0v, r0p)
    }
#undef ATT_STEP
#pragma unroll
    for (int qk = 0; qk < 2; ++qk) { const float lt = quad_sum(lrun[qk]); const float inv = 1.0f / lt;
        bf16_t* op = O + (tok0 + qb * 256 + wid * 32 + qk * 16 + l15) * 512 + h * 64 + 4 * quad;
#pragma unroll
        for (int d = 0; d < 4; ++d) { const f32x4 v = o[d][qk] * inv; u32x2 w; w.x = cvt_pk_bf16(v[0], v[1]); w.y = cvt_pk_bf16(v[2], v[3]); *(u32x2*)(op + 16 * d) = w; }
    }
}
__device__ __forceinline__ void attn_phase(const Ctx& a, LAS unsigned char* lds, int tid, int wid, int lane, int G, int c) {
    for (int i = 0;; ++i) { const int L = i * G + ((i & 1) ? (G - 1 - c) : c); if (L >= NBATCH * NHEAD * 8) break;
        const int qb = 7 - (L >> 7), bh = L & 127;
        attn_unit(a, lds, bh >> 3, bh & 7, qb, tid, wid, lane); }
}

#define XB_TMO      128
#define XB_XCNT(j)  (256  + 64 * (j))
#define XB_XSUB(j)  (1280 + 64 * (j))
#define XB_XGEN(j)  (2304 + 64 * (j))
#define XB_TOP      3328
#define XB_TOPGEN   3392
#define XCD_BAR_WORDS 3456
#define XB_SPIN_CAP (1u << 18)

__device__ __forceinline__ unsigned xb_ld(unsigned* p)              { return __hip_atomic_load(p, __ATOMIC_RELAXED, __HIP_MEMORY_SCOPE_AGENT); }
__device__ __forceinline__ unsigned xb_add(unsigned* p, unsigned v) { return __hip_atomic_fetch_add(p, v, __ATOMIC_RELAXED, __HIP_MEMORY_SCOPE_AGENT); }
__device__ __forceinline__ unsigned xb_xcc_id() { return (unsigned)__builtin_amdgcn_s_getreg((3 << 11) | 20) & 0xFu; }
#define XB_SPIN(cond, bar) do { unsigned _sp = 0; while (cond) { __builtin_amdgcn_s_sleep(1); \
    if ((++_sp & 255u) == 0u) { if (xb_ld(&(bar)[XB_TMO])) break; if (_sp > XB_SPIN_CAP) { atomicAdd(&(bar)[XB_TMO], 1u); break; } } } } while (0)

struct XcdBarrier {
    unsigned* bar; unsigned x;
    volatile LAS unsigned* st;
};

__device__ __forceinline__ XcdBarrier xcd_barrier_post(unsigned* bar, volatile LAS unsigned* st) {
    XcdBarrier b; b.bar = bar; b.x = xb_xcc_id(); b.st = st;
    if (threadIdx.x == 0) (void)xb_add(&bar[XB_XCNT(b.x)], 1u);
    return b;
}
__device__ __forceinline__ void xcd_barrier_complete(unsigned* bar, unsigned x, unsigned& nloc, unsigned& nx) {
    const unsigned G = gridDim.x * gridDim.y * gridDim.z;
    unsigned sum, cnt, mine, sp = 0u;
    for (;;) {
        sum = 0u; cnt = 0u; mine = 0u;
#pragma unroll
        for (unsigned j = 0; j < 16; ++j) { const unsigned c = xb_ld(&bar[XB_XCNT(j)]); sum += c; cnt += (c > 0u) ? 1u : 0u; mine = (j == x) ? c : mine; }
        if (sum == G) break;
        __builtin_amdgcn_s_sleep(1);
        if ((++sp & 255u) == 0u) { if (xb_ld(&bar[XB_TMO])) break; if (sp > XB_SPIN_CAP) { atomicAdd(&bar[XB_TMO], 1u); break; } }
    }
    nloc = mine > 0u ? mine : 1u; nx = cnt > 0u ? cnt : 1u;
}

__device__ __forceinline__ void xcd_barrier(const XcdBarrier& b) {
    asm volatile("s_waitcnt vmcnt(0)" ::: "memory");
    __syncthreads();
    if (threadIdx.x == 0) {
        unsigned* bar = b.bar;
        __builtin_amdgcn_s_waitcnt(0);
        unsigned nloc = b.st[0], nx = b.st[1];
        if (nloc == 0u) { xcd_barrier_complete(bar, b.x, nloc, nx); b.st[0] = nloc; b.st[1] = nx; }
        const unsigned old = xb_add(&bar[XB_XSUB(b.x)], 1u);
        const unsigned gen = old / nloc;
        if (old + 1u == (gen + 1u) * nloc) {
            __builtin_amdgcn_fence(__ATOMIC_RELEASE, "agent");
            asm volatile("s_waitcnt vmcnt(0)" ::: "memory");
            const unsigned og = xb_add(&bar[XB_TOP], 1u);
            const unsigned tg = og / nx;
            if (og + 1u == (tg + 1u) * nx) xb_add(&bar[XB_TOPGEN], 1u);
            else XB_SPIN(xb_ld(&bar[XB_TOPGEN]) == tg, bar);
            __builtin_amdgcn_fence(__ATOMIC_ACQUIRE, "agent");
            xb_add(&bar[XB_XGEN(b.x)], 1u);
            asm volatile("s_waitcnt vmcnt(0)" ::: "memory");
        } else {
            XB_SPIN(xb_ld(&bar[XB_XGEN(b.x)]) == gen, bar);
            __builtin_amdgcn_fence(__ATOMIC_ACQUIRE, "agent");
            asm volatile("s_waitcnt vmcnt(0)" ::: "memory");
        }
    }
    __syncthreads();
}


template <int MASK> __global__ void __launch_bounds__(512, 2) mega_fwd(Args ka) {
    extern __shared__ __attribute__((aligned(16))) unsigned char lds_raw[];
    LAS unsigned char* lds = (LAS unsigned char*)lds_raw;
    cg::grid_group grid = cg::this_grid();
    volatile LAS unsigned* bst = (volatile LAS unsigned*)(lds + 131072);
    if (threadIdx.x < 2) bst[threadIdx.x] = 0u;
    __syncthreads();
    const XcdBarrier xbar = xcd_barrier_post((unsigned*)(ka.ws + OFF_BAR), bst);
    if (ka.ph_lo == 0) {
        if (threadIdx.x == 0) { long long* tb = (long long*)(ka.ws + OFF_PTRS);
#pragma unroll
            for (int i = 0; i < 26; ++i) tb[i] = (long long)((const unsigned char*)ka.in[i] - ka.ws);
            tb[26] = (long long)((const unsigned char*)ka.out - ka.ws); }
        __syncthreads();
    }
#ifdef DUP_MASK
    int ph = ka.ph_lo - 1, rep = 1;
    for (;;) {
        if (rep == 0 && ph > 0 && ((DUP_MASK >> ((ph - 1) % 11)) & 1)) rep = 1; else { rep = 0; ++ph; }
        if (ph >= ka.ph_hi) break;
        if (ph > 0 && ((ph - 1) % 11 == 6 || (ph - 1) % 11 == 10)) continue;
        if (ph > ka.ph_lo) { if (ph == ka.ph_lo + 1) grid.sync(); else xcd_barrier(xbar); }
#ifdef EXTRA_SYNCS
        for (int es = 0; es < EXTRA_SYNCS; ++es) grid.sync();
#endif
#else
    for (int ph = ka.ph_lo; ph < ka.ph_hi; ++ph) {
        if (ph > 0 && ((ph - 1) % 11 == 6 || (ph - 1) % 11 == 10)) continue;
        if (ph > ka.ph_lo) { if (ph == ka.ph_lo + 1) grid.sync(); else xcd_barrier(xbar); }
#endif
        int tid_o = threadIdx.x; asm volatile("" : "+v"(tid_o));
        const int tid = tid_o, lane = tid & 63, wid = __builtin_amdgcn_readfirstlane(tid >> 6);
        size_t zoff = 0; asm volatile("" : "+s"(zoff));
        unsigned char* ws = ka.ws + zoff;
        const float epsv = __uint_as_float(0x358637bdu + (unsigned)zoff);
        int G = gridDim.x, cu = blockIdx.x; asm volatile("" : "+s"(G), "+s"(cu));
        const Ctx a{ws, (const long long*)(ws + OFF_PTRS), (float*)(ws + ((const long long*)(ws + OFF_PTRS))[26])};
        bf16_t* Wb = (bf16_t*)(ws + WS_W);
        float* ssx = (float*)(ws + WS_SSX); unsigned long long* gran = (unsigned long long*)(ws + WS_GRAN); float* ssq = (float*)(ws + OFF_SSQ); float* sskv = (float*)(ws + OFF_SSKV); float* ssy = (float*)(ws + OFF_SSY);
        const float* rope = (const float*)(ws + OFF_ROPE);
        bf16_t* XY = (bf16_t*)(ws + WS_XY);
        if (ph == 0) { if constexpr ((MASK >> 11) & 1) { init_phase(a, tid, wid, lane, G, cu, epsv); prep_layer(a, 0, lds, tid, wid, lane, G, cu, 0); } continue; }
        const int l = (ph - 1) / 11, sp = (ph - 1) % 11;
        switch (sp) {
        case 0: if constexpr ((MASK >> 0) & 1) {
            Gemm g{XY, Wb + WE_IN, DM, DM, DM, 0, 0}; StaticOrder S; S.init(T_TOK, INP, G, cu);
            EpiIn E{ssx, epsv, (bf16_t*)(ws + WS_CQ), (bf16_t*)(ws + WS_KPE), (bf16_t*)(ws + WS_CKV), (bf16_t*)(ws + WS_UP), (bf16_t*)(ws + WS_GATES), a.inp(I_BGATE) + (size_t)l * 2048, ssq, sskv, rope};
            gemm_phase<EpiIn, StaticOrder, true, true>(lds, g, S, E);
            if (cu >= G / 2) prep_layer(a, l, lds, tid, wid, lane, G, cu, 1);
        } break;
        case 1: if constexpr ((MASK >> 1) & 1) {
            if constexpr ((MASK >> 12) & 1) { Gemm g{(const bf16_t*)(ws + WS_CQ), Wb + WE_UQ, QL, QL, QL, 0, 0}; StaticOrder S; S.init(T_TOK, 768, G, cu);
              EpiQ E{ssq, (bf16_t*)(ws + WS_Q), rope, 0.10206207261596577f * 1.4426950408889634f, epsv};
              gemm_phase<EpiQ, StaticOrder, true, true>(lds, g, S, E); }
            if constexpr ((MASK >> 13) & 1) { Gemm g{(const bf16_t*)(ws + WS_UP), Wb + WE_WST, KS5, 512, 512, (size_t)NCHR * KS5, (size_t)256 * 512}; BatchOrder S; S.init(NCHR, 256, NGRP, G, (cu + G / 2) % G);
              EpiState E{(float*)(ws + WS_SST)};
              gemm_phase<EpiState, BatchOrder, true, true>(lds, g, S, E); }
            if constexpr ((MASK >> 14) & 1) { Gemm g{(const bf16_t*)(ws + WS_CKV), Wb + WE_UKV, KVL, KVL, KVL, 0, 0}; StaticOrder S; S.init(T_TOK, 1024, G, cu);
              EpiKV E{sskv, (bf16_t*)(ws + WS_KN), (bf16_t*)(ws + WS_V), epsv};
              gemm_phase<EpiKV, StaticOrder, true, true>(lds, g, S, E); }
        } break;
        case 2: if constexpr ((MASK >> 2) & 1) {
            carry_phase(a, tid, G, cu);
            attn_phase(a, lds, tid, wid, lane, G, cu);
        } break;
        case 3: if constexpr ((MASK >> 3) & 1) {
            { Gemm g{(const bf16_t*)(ws + WS_O), Wb + WE_OATT, 512, 512, 512, 0, 0}; StaticOrder S; S.init(T_TOK, DM, G, cu);
              EpiOatt E{(const bf16_t*)(ws + WS_GATES), (bf16_t*)(ws + WS_MERGED)};
              gemm_phase<EpiOatt, StaticOrder, true, true>(lds, g, S, E); }
            { Gemm g{(const bf16_t*)(ws + WS_UP), Wb + WE_TV, KS5, KS5, KS5, (size_t)NCHR * KS5, (size_t)512 * KS5}; BatchOrder S; S.init(NCHR, 512, NGRP, G, cu);
              EpiS5 E{(bf16_t*)(ws + WS_YS5)};
              gemm_phase<EpiS5, BatchOrder, true, true>(lds, g, S, E); }
        } break;
        case 4: if constexpr ((MASK >> 4) & 1) {
            Gemm g{(const bf16_t*)(ws + WS_YS5), Wb + WE_GLU, SSMW, SSMW, SSMW, 0, 0}; StaticOrder S; S.init(T_TOK, 2048, G, cu);
            EpiGlu E{(const bf16_t*)(ws + WS_GATES), (bf16_t*)(ws + WS_MERGED)};
            gemm_phase<EpiGlu, StaticOrder, true, true>(lds, g, S, E);
        } break;
        case 5: if constexpr ((MASK >> 5) & 1) {
            Gemm g{(const bf16_t*)(ws + WS_MERGED), Wb + WE_OUT, DM, DM, DM, 0, 0}; StaticOrder S; S.init(T_TOK, DM, G, cu);
            EpiYN E{XY, nullptr, a.inp(I_GMIXPOST) + (size_t)l * DM, gran, ssx, (unsigned)(l * 2 + 1), epsv, (LAS float*)(lds + 131072 + 64)};
            gemm_phase<EpiYN, StaticOrder, true, true>(lds, g, S, E);
        } break;
        case 6: break;
        case 7: if constexpr ((MASK >> 7) & 1) {
            Gemm g{XY, Wb + WE_UP, DM, DM, DM, 0, 0}; StaticOrder S; S.init(T_TOK, 2 * DFF, G, cu);
            EpiUpConv E{ssx, epsv, a.inp(I_CONVW) + (size_t)l * 3 * DFF, a.inp(I_CONVB) + (size_t)l * DFF, (bf16_t*)(ws + WS_VAL), (float*)(ws + WS_GL), (float*)(ws + WS_GF), (float*)(ws + WS_VF), (LAS float*)(lds + 131072 + 64)};
            gemm_phase<EpiUpConv, StaticOrder, true, true>(lds, g, S, E);
        } break;
        case 8: if constexpr ((MASK >> 8) & 1) { conv_fixup_phase(a, l, tid, G, cu);
            if (l + 1 < DEPTH) prep_layer(a, l + 1, lds, tid, wid, lane, G, cu, 0);
        } break;
        case 9: if constexpr ((MASK >> 9) & 1) {
            Gemm g{(const bf16_t*)(ws + WS_VAL), Wb + WE_DOWN, DFF, DFF, DFF, 0, 0}; StaticOrder S; S.init(T_TOK, DM, G, cu);
            EpiYN E{XY, (l + 1 == DEPTH) ? a.out : nullptr, a.inp(I_GFFNPOST) + (size_t)l * DM, gran, ssx, (unsigned)(l * 2 + 2), epsv, (LAS float*)(lds + 131072 + 64)};
            gemm_phase<EpiYN, StaticOrder, true, true>(lds, g, S, E);
        } break;
        case 10: if constexpr ((MASK >> 10) & 1) {
        } break;
        }
    }
}

#ifndef N_LAUNCH_MODE
#define N_LAUNCH_MODE 1
#endif
#ifndef GEMM_MASK_V
#define GEMM_MASK_V 0x7ABB
#endif
constexpr int GEMM_MASK = GEMM_MASK_V, OTHER_MASK = 0xD44;
extern "C" void kernel_launch(void* const* d_in, const int* in_sizes, int n_in, void* d_out, int out_size, void* d_ws, size_t ws_size, hipStream_t stream) {
    static int grid = 0;
    if (grid == 0) {
        if (n_in != 26 || out_size != T_TOK * DM || ws_size < WS_END) { fprintf(stderr, "kernel_launch: unexpected shapes (n_in %d out %d ws %zu)\n", n_in, out_size, ws_size); grid = -1; return; }
        int dev = 0, cus = 0;
        (void)hipGetDevice(&dev); (void)hipDeviceGetAttribute(&cus, hipDeviceAttributeMultiprocessorCount, dev);
#if N_LAUNCH_MODE == 1
        (void)hipFuncSetAttribute((const void*)mega_fwd<0x7FFF>, hipFuncAttributeMaxDynamicSharedMemorySize, LDS_BYTES);
#else
        (void)hipFuncSetAttribute((const void*)mega_fwd<GEMM_MASK>, hipFuncAttributeMaxDynamicSharedMemorySize, LDS_BYTES);
        (void)hipFuncSetAttribute((const void*)mega_fwd<OTHER_MASK>, hipFuncAttributeMaxDynamicSharedMemorySize, LDS_BYTES);
#endif
        grid = cus > 0 ? cus : 256;
        (void)hipGetLastError();
    }
    if (grid < 0) return;
    Args a{};
    for (int i = 0; i < 26; ++i) a.in[i] = (const float*)d_in[i];
    a.out = (float*)d_out; a.ws = (unsigned char*)d_ws;
#if N_LAUNCH_MODE == 1
    a.ph_lo = 0; a.ph_hi = 1 + 11 * DEPTH;
    (void)hipMemsetAsync((char*)d_ws + OFF_BAR, 0, XCD_BAR_WORDS * 4, stream);
    (void)hipMemsetAsync((char*)d_ws + WS_GRAN, 0, GRAN_BYTES, stream);
    void* args[] = {&a};
    hipError_t e = hipLaunchCooperativeKernel((const void*)mega_fwd<0x7FFF>, dim3(grid), dim3(512), args, LDS_BYTES, stream);
    if (e != hipSuccess) fprintf(stderr, "cooperative launch failed: %s (grid %d)\n", hipGetErrorString(e), grid);
#else
    for (int ph = 0; ph < 1 + 11 * DEPTH; ++ph) {
        a.ph_lo = ph; a.ph_hi = ph + 1;
        const int sp = ph == 0 ? 11 : (ph - 1) % 11;
        if ((0x2BB >> sp) & 1) hipLaunchKernelGGL(mega_fwd<GEMM_MASK>, dim3(grid), dim3(512), LDS_BYTES, stream, a);
        else hipLaunchKernelGGL(mega_fwd<OTHER_MASK>, dim3(grid), dim3(512), LDS_BYTES, stream, a);
    }
#endif
}
```

```cpp
#include <hip/hip_runtime.h>
#include <hip/hip_cooperative_groups.h>
#include <cstdio>
#include <cstdint>
namespace cg = cooperative_groups;

#define LAS __attribute__((address_space(3)))
#define PG8_LAS __attribute__((address_space(3)))
typedef unsigned short bf16_t;
typedef short bf16x8 __attribute__((ext_vector_type(8)));
typedef short s16x4 __attribute__((ext_vector_type(4)));
typedef float f32x4 __attribute__((ext_vector_type(4)));
typedef float f32x2 __attribute__((ext_vector_type(2)));
typedef unsigned u32x4 __attribute__((ext_vector_type(4)));
typedef unsigned u32x2 __attribute__((ext_vector_type(2)));

constexpr int T_TOK = 32768, DM = 1024, SEQ = 2048, NBATCH = 16, DEPTH = 4;
constexpr int QL = 384, KVL = 256, ROPE_D = 32, SSMW = 512, INC = 3232, INP = 3328;
constexpr int NHEAD = 8, QKD = 96, DFF = 2816;
constexpr int LCH = 32, NCHR = T_TOK / LCH  , KS5 = 640, NGRP = 32, NST = 64;
constexpr float EPS = 1e-6f;

constexpr int BM = 256, BK = 64, HALF = 128, HTB = HALF * BK * 2, STAGE_BYTES = 8 * HTB, NXCD = 8, WGM = 8;

__host__ __device__ __forceinline__ int lds_byte(int r, int c) { const int st = (r >> 4) * 2 + (c >> 5), rr = r & 15, cc = c & 31, ob = rr * 64 + cc * 2; return st * 1024 + (ob ^ (((ob >> 9) & 1) << 5)); }
__host__ __device__ __forceinline__ void stage_rc(int b, int& R, int& C) { const int st = b / 1024, sb = b % 1024, swz = sb ^ (((sb >> 9) & 1) << 5); R = (st >> 1) * 16 + swz / 64; C = (st & 1) * 32 + (swz % 64) / 2; }
__host__ __device__ __forceinline__ int perm32(int rho) { const int n = rho >> 4, i = rho & 15; return 8 * (i >> 2) + 4 * n + (i & 3); }

struct Unit { int pm, pn, z; };
struct Gemm { const bf16_t* A; const bf16_t* Bt; int lda, ldb, K; size_t zA, zB; };

struct StaticOrder {
    int nM, nN, nwg, G, c;
    __host__ __device__ void init(int M, int N, int G_, int c_) { nM = M / BM; nN = N / BM; nwg = nM * nN; G = G_; c = c_; }
    __host__ __device__ bool next(int i, Unit& u) const {
        const long L = (long)i * G + c; if (L >= nwg) return false;
        int wgid = (int)L; { const int q = nwg / NXCD, r = nwg % NXCD, xcd = wgid % NXCD, off = wgid / NXCD; wgid = (xcd < r ? xcd * (q + 1) : r * (q + 1) + (xcd - r) * q) + off; }
        const int nig = WGM * nN, gid = wgid / nig, fm = gid * WGM, gsz = (nM - fm) < WGM ? (nM - fm) : WGM;
        u.pm = fm + ((wgid % nig) % gsz); u.pn = (wgid % nig) / gsz; u.z = 0; return true;
    }
    __device__ __forceinline__ void a_ready(const Unit&) const {}
    __device__ __forceinline__ void done(const Unit&) const {}
};
struct BatchOrder {
    int nM, nN, nz, G, c;
    __host__ __device__ void init(int M, int N, int nz_, int G_, int c_) { nM = M / BM; nN = N / BM; nz = nz_; G = G_; c = c_; }
    __host__ __device__ bool next(int i, Unit& u) const {
        const long L = (long)i * G + c; if (L >= (long)nz * nM * nN) return false;
        const int per = nM * nN; u.z = (int)(L / per); const int r = (int)(L % per); u.pn = r / nM; u.pm = r % nM; return true;
    }
    __device__ __forceinline__ void a_ready(const Unit&) const {}
    __device__ __forceinline__ void done(const Unit&) const {}
};

typedef __bf16 bf16x2_t __attribute__((ext_vector_type(2)));
__device__ __forceinline__ unsigned cvt_pk_bf16(float lo, float hi) { const f32x2 v = {lo, hi}; const bf16x2_t b = __builtin_convertvector(v, bf16x2_t); return __builtin_bit_cast(unsigned, b); }
__device__ __forceinline__ float bf_lo(unsigned w) { return __uint_as_float(w << 16); }
__device__ __forceinline__ float bf_hi(unsigned w) { return __uint_as_float(w & 0xffff0000u); }
__device__ __forceinline__ float shx(float x, int k, int lane) { return __builtin_bit_cast(float, __builtin_amdgcn_ds_bpermute((lane ^ k) << 2, __builtin_bit_cast(int, x))); }
__device__ __forceinline__ float sigmoid_f(float x) { return __builtin_amdgcn_rcpf(1.0f + __builtin_amdgcn_exp2f(x * -1.4426950408889634f)); }
__device__ __forceinline__ float gelu_tanh(float x) {
    const float K1 = 2.0f * 0.7978845608028654f * 1.4426950408889634f, K2 = K1 * 0.044715f;
    const float a = fmaf(x * x, K2, K1); return x * __builtin_amdgcn_rcpf(1.0f + __builtin_amdgcn_exp2f(-x * a)); }
__device__ __forceinline__ u32x4 pack8(const f32x4 a, const f32x4 b) { u32x4 w; w.x = cvt_pk_bf16(a[0], a[1]); w.y = cvt_pk_bf16(a[2], a[3]); w.z = cvt_pk_bf16(b[0], b[1]); w.w = cvt_pk_bf16(b[2], b[3]); return w; }

template <class Epi, class Sched, bool ALIGN_EPI = false, bool SP2 = false>
__device__ __forceinline__ void gemm_phase(PG8_LAS unsigned char* lds, const Gemm g, const Sched& S, const Epi& E) {
    int tid_o = threadIdx.x; asm volatile("" : "+v"(tid_o));
    const int tid = tid_o, wid = __builtin_amdgcn_readfirstlane(tid >> 6), lane = tid & 63, wr = wid >> 2, wc = wid & 3, fr = lane & 15, fq = lane >> 4;
    const int K = g.K, nt = K / BK;
    unsigned voffA[2], voffB[2];
#pragma unroll
    for (int i = 0; i < 2; ++i) { int R, C; stage_rc(tid * 16 + i * 8192, R, C); const int Rb = Epi::PERM ? ((R & ~31) + perm32(R & 31)) : R;
        voffA[i] = (unsigned)(R * g.lda + C) * 2u; voffB[i] = (unsigned)(Rb * g.ldb + C) * 2u; }
    const size_t kstep = (size_t)(BK * 2);
    const size_t hstepA = (size_t)HALF * g.lda * 2, hstepB = (size_t)HALF * g.ldb * 2;
    const size_t tstepA = 2 * hstepA, tstepB = 2 * hstepB;
    const unsigned ldsw = (unsigned)wid * 1024u;
    const int aoff = lds_byte(wr * 64 + fr, fq * 8), boff = lds_byte(wc * 32 + fr, fq * 8);
#define PG8_SA(b, h) (((b) * 2 + (h)) * HTB)
#define PG8_SB(b, h) ((4 + (b) * 2 + (h)) * HTB)
#define PG8_STAGE(bufoff, gbase, voff) do { _Pragma("unroll") for (int _i = 0; _i < 2; ++_i) \
        __builtin_amdgcn_global_load_lds((const unsigned*)((const char*)(gbase) + (voff)[_i]), (PG8_LAS unsigned*)(lds + (bufoff) + ldsw + _i * 8192), 16, 0, 0); } while (0)
#define PG8_LDA(dst, b, h) do { _Pragma("unroll") for (int m = 0; m < 4; ++m) _Pragma("unroll") for (int k = 0; k < 2; ++k) dst[m][k] = *(const PG8_LAS bf16x8*)(lds + PG8_SA(b, h) + aoff + m * 2048 + k * 1024); } while (0)
#define PG8_LDB(dst, b, h) do { _Pragma("unroll") for (int n = 0; n < 2; ++n) _Pragma("unroll") for (int k = 0; k < 2; ++k) dst[n][k] = *(const PG8_LAS bf16x8*)(lds + PG8_SB(b, h) + boff + n * 2048 + k * 1024); } while (0)
#define PG8_MMA(ai, bj, At, Bt) do { __builtin_amdgcn_s_setprio(1); _Pragma("unroll") for (int m = 0; m < 4; ++m) _Pragma("unroll") for (int n = 0; n < 2; ++n) _Pragma("unroll") for (int k = 0; k < 2; ++k) \
        acc[ai][bj][m][n] = __builtin_amdgcn_mfma_f32_16x16x32_bf16(Bt[n][k], At[m][k], acc[ai][bj][m][n], 0, 0, 0); __builtin_amdgcn_s_setprio(0); } while (0)
#define PG8_WAIT_V(n) asm volatile("s_waitcnt vmcnt(" #n ")" ::: "memory")
#define PG8_WAIT_L(n) asm volatile("s_waitcnt lgkmcnt(" #n ")" ::: "memory")
#define PG8_BAR __builtin_amdgcn_s_barrier()
#define PG8_SCHED __builtin_amdgcn_sched_barrier(0)
    Unit cur, nxt; int ui = 0;
    if (!S.next(0, cur)) return;
    f32x4 acc[2][2][4][2];
#pragma unroll
    for (int a = 0; a < 2; ++a)
#pragma unroll
        for (int b = 0; b < 2; ++b)
#pragma unroll
            for (int m = 0; m < 4; ++m)
#pragma unroll
                for (int n = 0; n < 2; ++n) acc[a][b][m][n] = (f32x4){0.f, 0.f, 0.f, 0.f};
    bf16x8 At[4][2], B0[2][2], B1[2][2];
    const char* cA = (const char*)g.A + (size_t)cur.z * g.zA * 2 + (size_t)cur.pm * tstepA; const char* cB = (const char*)g.Bt + (size_t)cur.z * g.zB * 2 + (size_t)cur.pn * tstepB;
    S.a_ready(cur);
    if constexpr (SP2) {
        PG8_STAGE(PG8_SB(0, 0), cB, voffB); PG8_STAGE(PG8_SB(0, 1), cB + hstepB, voffB); PG8_STAGE(PG8_SA(0, 0), cA, voffA); PG8_STAGE(PG8_SA(0, 1), cA + hstepA, voffA);
        if (wr == 1) PG8_BAR;
        PG8_WAIT_V(2); PG8_BAR;
        PG8_STAGE(PG8_SB(1, 0), cB + kstep, voffB); PG8_STAGE(PG8_SA(1, 0), cA + kstep, voffA); PG8_STAGE(PG8_SB(1, 1), cB + hstepB + kstep, voffB);
        PG8_WAIT_V(6); PG8_BAR;
    } else {
        PG8_STAGE(PG8_SB(0, 0), cB, voffB); PG8_STAGE(PG8_SA(0, 0), cA, voffA); PG8_STAGE(PG8_SB(0, 1), cB + hstepB, voffB); PG8_STAGE(PG8_SA(0, 1), cA + hstepA, voffA);
        if (wr == 1) PG8_BAR;
        PG8_WAIT_V(4); PG8_BAR;
        PG8_STAGE(PG8_SB(1, 0), cB + kstep, voffB); PG8_STAGE(PG8_SA(1, 0), cA + kstep, voffA); PG8_STAGE(PG8_SB(1, 1), cB + hstepB + kstep, voffB);
        PG8_WAIT_V(6); PG8_BAR;
    }
    for (;;) {
        const bool has_next = S.next(ui + 1, nxt);
        const char* nA = has_next ? (const char*)g.A + (size_t)nxt.z * g.zA * 2 + (size_t)nxt.pm * tstepA : cA; const char* nB = has_next ? (const char*)g.Bt + (size_t)nxt.z * g.zB * 2 + (size_t)nxt.pn * tstepB : cB;
        for (int t = 0; t < nt; t += 2) {
            const bool last = (t == nt - 2);
            const char* a1 = cA + (size_t)(t + 1) * kstep;
            const char* a2 = last ? nA : cA + (size_t)(t + 2) * kstep; const char* b2 = last ? nB : cB + (size_t)(t + 2) * kstep;
            const char* a3 = a2 + kstep; const char* b3 = b2 + kstep;
            if (last && has_next) S.a_ready(nxt);
            if constexpr (SP2) {
            PG8_LDB(B0, 0, 0); PG8_LDB(B1, 0, 1); PG8_SCHED; PG8_LDA(At, 0, 0); PG8_STAGE(PG8_SA(1, 1), a1 + hstepA, voffA);
            PG8_WAIT_V(8); PG8_WAIT_L(0); PG8_BAR; PG8_MMA(0, 0, At, B0); PG8_MMA(0, 1, At, B1); PG8_BAR; PG8_SCHED;
            PG8_LDA(At, 0, 1); PG8_STAGE(PG8_SB(0, 0), b2, voffB); PG8_STAGE(PG8_SB(0, 1), b2 + hstepB, voffB); PG8_STAGE(PG8_SA(0, 0), a2, voffA);
            PG8_WAIT_V(8); PG8_WAIT_L(0); PG8_BAR; PG8_MMA(1, 0, At, B0); PG8_MMA(1, 1, At, B1); PG8_BAR; PG8_SCHED;
            PG8_LDB(B0, 1, 0); PG8_LDB(B1, 1, 1); PG8_SCHED; PG8_LDA(At, 1, 0); PG8_STAGE(PG8_SA(0, 1), a2 + hstepA, voffA);
            PG8_WAIT_V(8); PG8_WAIT_L(0); PG8_BAR; PG8_MMA(0, 0, At, B0); PG8_MMA(0, 1, At, B1); PG8_BAR; PG8_SCHED;
            PG8_LDA(At, 1, 1); PG8_STAGE(PG8_SB(1, 0), b3, voffB); PG8_STAGE(PG8_SB(1, 1), b3 + hstepB, voffB); PG8_STAGE(PG8_SA(1, 0), a3, voffA);
            PG8_WAIT_V(8); PG8_WAIT_L(0); PG8_BAR; PG8_MMA(1, 0, At, B0); PG8_MMA(1, 1, At, B1); PG8_BAR; PG8_SCHED;
            } else {
            PG8_LDB(B0, 0, 0); PG8_SCHED; PG8_LDA(At, 0, 0); PG8_STAGE(PG8_SA(1, 1), a1 + hstepA, voffA);
            PG8_WAIT_L(8); PG8_BAR; PG8_WAIT_L(0); PG8_MMA(0, 0, At, B0); PG8_BAR; PG8_SCHED;
            PG8_LDB(B1, 0, 1); PG8_STAGE(PG8_SB(0, 0), b2, voffB);
            PG8_BAR; PG8_WAIT_L(0); PG8_MMA(0, 1, At, B1); PG8_BAR;
            PG8_LDA(At, 0, 1); PG8_STAGE(PG8_SA(0, 0), a2, voffA);
            PG8_BAR; PG8_WAIT_L(0); PG8_MMA(1, 0, At, B0); PG8_BAR; PG8_SCHED;
            PG8_STAGE(PG8_SB(0, 1), b2 + hstepB, voffB);
            PG8_WAIT_V(6); PG8_BAR; PG8_MMA(1, 1, At, B1); PG8_BAR;
            PG8_LDB(B0, 1, 0); PG8_SCHED; PG8_LDA(At, 1, 0); PG8_STAGE(PG8_SA(0, 1), a2 + hstepA, voffA);
            PG8_WAIT_L(8); PG8_BAR; PG8_WAIT_L(0); PG8_MMA(0, 0, At, B0); PG8_BAR; PG8_SCHED;
            PG8_LDB(B1, 1, 1); PG8_STAGE(PG8_SB(1, 0), b3, voffB);
            PG8_BAR; PG8_WAIT_L(0); PG8_MMA(0, 1, At, B1); PG8_BAR;
            PG8_LDA(At, 1, 1); PG8_STAGE(PG8_SA(1, 0), a3, voffA);
            PG8_BAR; PG8_WAIT_L(0); PG8_MMA(1, 0, At, B0); PG8_BAR; PG8_SCHED;
            PG8_STAGE(PG8_SB(1, 1), b3 + hstepB, voffB);
            PG8_WAIT_V(6); PG8_BAR; PG8_MMA(1, 1, At, B1); PG8_BAR;
            }
        }
        if constexpr (ALIGN_EPI) { if (wr == 0) PG8_BAR; }
        if constexpr (!Epi::AFTER_DRAIN) { int lane_e; asm volatile("v_mbcnt_lo_u32_b32 %0, -1, 0\n\tv_mbcnt_hi_u32_b32 %0, -1, %0" : "=v"(lane_e)); E(acc, cur, wr, wc, lane_e & 15, lane_e >> 4); S.done(cur); }
        if (!has_next) break;
#pragma unroll
        for (int a = 0; a < 2; ++a)
#pragma unroll
            for (int b = 0; b < 2; ++b)
#pragma unroll
                for (int m = 0; m < 4; ++m)
#pragma unroll
                    for (int n = 0; n < 2; ++n) acc[a][b][m][n] = (f32x4){0.f, 0.f, 0.f, 0.f};
        cur = nxt; cA = nA; cB = nB; ++ui;
        if constexpr (ALIGN_EPI) { if (wr == 1) PG8_BAR; }
    }
    PG8_WAIT_V(0);
    if constexpr (!ALIGN_EPI) { if (wr == 0) PG8_BAR; }
    PG8_BAR;
    if constexpr (Epi::AFTER_DRAIN) { E.fused(acc, cur, wr, wc, fr, fq, lds, wid, lane); S.done(cur); }
#undef PG8_SA
#undef PG8_SB
#undef PG8_STAGE
#undef PG8_LDA
#undef PG8_LDB
#undef PG8_MMA
#undef PG8_WAIT_V
#undef PG8_WAIT_L
#undef PG8_BAR
#undef PG8_SCHED
}

constexpr size_t MiB = (size_t)1 << 20;
constexpr size_t OFF_RSTDX = 0, OFF_ROPE = 128 * 1024, OFF_AL = 384 * 1024, OFF_PTRS = 448 * 1024, OFF_BAR = 456 * 1024  , OFF_SSKV = 512 * 1024  , OFF_SSQ = 1024 * 1024  , OFF_SSY = 2048 * 1024  ;
constexpr size_t WS_W = 4 * MiB;
constexpr size_t WE_IN = 0, WE_UQ = 3407872, WE_UKV = 3702784, WE_OATT = 3964928, WE_GLU = 4489216, WE_OUT = 5537792, WE_UP = 6586368, WE_DOWN = 12353536, WE_TV = 15237120, WE_WST = 25722880;
constexpr size_t WS_SSX = 62 * MiB  , WS_SST4 = 61 * MiB + 512 * 1024  , WS_GRAN = 65 * MiB  , GRAN_BYTES = 4 * (size_t)32768 * 8;
constexpr size_t WS_XY = 68 * MiB;
constexpr size_t WS_GATES = 132 * MiB, WS_CQ = 260 * MiB, WS_CKV = 284 * MiB, WS_KPE = 300 * MiB, WS_UP = 302 * MiB, WS_Q = 342 * MiB, WS_KN = 390 * MiB, WS_V = 422 * MiB, WS_SST = 454 * MiB;
constexpr size_t WS_O = 260 * MiB, WS_MERGED = 342 * MiB, WS_YS5 = 422 * MiB;
constexpr size_t WS_G = 132 * MiB, WS_VAL = 308 * MiB;
constexpr size_t WS_YB = 132 * MiB;
constexpr size_t WS_GL = 484 * MiB, WS_GF = 488 * MiB, WS_VF = 492 * MiB;
constexpr size_t WS_END = 496 * MiB;

constexpr int LDS_BYTES = 131072 + 64 + 16384 + 64;
#ifndef PHMASK
#define PHMASK 0xFFF
#endif

#define EPI_ROWS_BEGIN _Pragma("unroll") for (int ai = 0; ai < 2; ++ai) _Pragma("unroll") for (int m = 0; m < 4; ++m) { const int row = u.pm * BM + ai * HALF + wr * 64 + m * 16 + fr;
#define EPI_ROWS_END }
__device__ __forceinline__ float sumsq8(const f32x4 a, const f32x4 b) { return (a[0] * a[0] + a[1] * a[1]) + (a[2] * a[2] + a[3] * a[3]) + (b[0] * b[0] + b[1] * b[1]) + (b[2] * b[2] + b[3] * b[3]); }
__device__ __forceinline__ void rope8(f32x4& v0, f32x4& v1, const float* rope, int pos, int fq) {
    const f32x4 cs0 = *(const f32x4*)(rope + (pos * 16 + 4 * fq) * 2), cs1 = *(const f32x4*)(rope + (pos * 16 + 4 * fq) * 2 + 4);
    const float c[4] = {cs0[0], cs0[2], cs1[0], cs1[2]}, s[4] = {cs0[1], cs0[3], cs1[1], cs1[3]};
    f32x4 o0, o1;
#pragma unroll
    for (int j = 0; j < 4; ++j) { o0[j] = v0[j] * c[j] - v1[j] * s[j]; o1[j] = v1[j] * c[j] + v0[j] * s[j]; }
    v0 = o0; v1 = o1;
}

__device__ __forceinline__ float row_rstd(const float* ssx, int row, float epsv, int lane, int fq) {
    const f32x4 a = *(const f32x4*)(ssx + (unsigned)row * 16 + 4 * fq); float t = (a[0] + a[1]) + (a[2] + a[3]); t += shx(t, 16, lane); t += shx(t, 32, lane);
    return rsqrtf(t * (1.0f / DM) + epsv);
}
struct EpiIn {
    static constexpr bool PERM = true, AFTER_DRAIN = false;
    const float* ssx; float epsv; bf16_t* CQ; bf16_t* KPE; bf16_t* CKV; bf16_t* UP; bf16_t* GATES; const float* bgate; float* ssq; float* sskv; const float* rope;
    __device__ __forceinline__ void operator()(const f32x4 (&acc)[2][2][4][2], const Unit& u, int wr, int wc, int fr, int fq) const {
        const int pn = u.pn, lane = fr | (fq << 4);
        float rsv[2][4];
#pragma unroll
        for (int ai = 0; ai < 2; ++ai)
#pragma unroll
            for (int m = 0; m < 4; ++m) rsv[ai][m] = row_rstd(ssx, u.pm * BM + ai * HALF + wr * 64 + m * 16 + fr, epsv, lane, fq);
        if (pn >= 5) {
            f32x4 b0[2], b1[2];
#pragma unroll
            for (int bj = 0; bj < 2; ++bj) { const int gcol = (pn - 5) * 256 + bj * HALF + wc * 32 + fq * 8; b0[bj] = *(const f32x4*)(bgate + gcol); b1[bj] = *(const f32x4*)(bgate + gcol + 4); }
            EPI_ROWS_BEGIN
                const float rs = rsv[ai][m];
#pragma unroll
                for (int bj = 0; bj < 2; ++bj) { const int gcol = (pn - 5) * 256 + bj * HALF + wc * 32 + fq * 8;
                    f32x4 v0 = acc[ai][bj][m][0] * rs + b0[bj], v1 = acc[ai][bj][m][1] * rs + b1[bj];
#pragma unroll
                    for (int j = 0; j < 4; ++j) { v0[j] = sigmoid_f(v0[j]); v1[j] = sigmoid_f(v1[j]); }
                    *(u32x4*)(GATES + (unsigned)row * 2048 + gcol) = pack8(v0, v1); }
            EPI_ROWS_END
        } else if (pn >= 3) {
            EPI_ROWS_BEGIN
                const float rs = rsv[ai][m];
#pragma unroll
                for (int bj = 0; bj < 2; ++bj) { const f32x4 v0 = acc[ai][bj][m][0] * rs, v1 = acc[ai][bj][m][1] * rs;
                    const int ucol = (pn - 3) * 256 + bj * HALF + wc * 32 + fq * 8; const int g = ucol >> 4, h0 = ucol & 15;
                    *(u32x4*)(UP + (unsigned)(g * NCHR + (row >> 5)) * KS5 + (row & 31) * 16 + h0) = pack8(v0, v1); }
            EPI_ROWS_END
        } else if (pn == 2) {
            EPI_ROWS_BEGIN
                const float rs = rsv[ai][m]; float ss = 0.f;
#pragma unroll
                for (int bj = 0; bj < 2; ++bj) { const f32x4 v0 = acc[ai][bj][m][0] * rs, v1 = acc[ai][bj][m][1] * rs; ss += sumsq8(v0, v1);
                    *(u32x4*)(CKV + (unsigned)row * KVL + bj * HALF + wc * 32 + fq * 8) = pack8(v0, v1); }
                ss += shx(ss, 16, lane); ss += shx(ss, 32, lane);
                if (fq == 0) sskv[row * 4 + wc] = ss;
            EPI_ROWS_END
        } else if (pn == 1) {
            EPI_ROWS_BEGIN
                const float rs = rsv[ai][m];
                { const f32x4 v0 = acc[ai][0][m][0] * rs, v1 = acc[ai][0][m][1] * rs; float ss = sumsq8(v0, v1);
                  *(u32x4*)(CQ + (unsigned)row * QL + 256 + wc * 32 + fq * 8) = pack8(v0, v1);
                  ss += shx(ss, 16, lane); ss += shx(ss, 32, lane);
                  if (fq == 0) ssq[row * 8 + 4 + wc] = ss; }
                if (wc == 0) { f32x4 v0 = acc[ai][1][m][0] * rs, v1 = acc[ai][1][m][1] * rs; rope8(v0, v1, rope, row & (SEQ - 1), fq);
                  *(u32x4*)(KPE + (unsigned)row * ROPE_D + fq * 8) = pack8(v0, v1); }
            EPI_ROWS_END
        } else {
            EPI_ROWS_BEGIN
                const float rs = rsv[ai][m]; float ss = 0.f;
#pragma unroll
                for (int bj = 0; bj < 2; ++bj) { const f32x4 v0 = acc[ai][bj][m][0] * rs, v1 = acc[ai][bj][m][1] * rs; ss += sumsq8(v0, v1);
                    *(u32x4*)(CQ + (unsigned)row * QL + bj * HALF + wc * 32 + fq * 8) = pack8(v0, v1); }
                ss += shx(ss, 16, lane); ss += shx(ss, 32, lane);
                if (fq == 0) ssq[row * 8 + wc] = ss;
            EPI_ROWS_END
        }
    }
};

struct EpiQ {
    static constexpr bool PERM = true, AFTER_DRAIN = false;
    const float* ssq; bf16_t* Q; const float* rope; float c2, epsv;
    __device__ __forceinline__ void operator()(const f32x4 (&acc)[2][2][4][2], const Unit& u, int wr, int wc, int fr, int fq) const {
        EPI_ROWS_BEGIN
            const f32x4 sa = *(const f32x4*)(ssq + row * 8), sb = *(const f32x4*)(ssq + row * 8 + 4);
            const float rs = rsqrtf((((sa[0] + sa[1]) + (sa[2] + sa[3])) + ((sb[0] + sb[1]) + (sb[2] + sb[3]))) * (1.0f / QL) + epsv) * c2;
#pragma unroll
            for (int bj = 0; bj < 2; ++bj) { f32x4 v0 = acc[ai][bj][m][0] * rs, v1 = acc[ai][bj][m][1] * rs;
                const int gi = u.pn * 8 + bj * 4 + wc;
                if (gi % 3 == 2) rope8(v0, v1, rope, row & (SEQ - 1), fq);
                *(u32x4*)(Q + (unsigned)row * 768 + u.pn * 256 + bj * HALF + wc * 32 + fq * 8) = pack8(v0, v1); }
        EPI_ROWS_END
    }
};
struct EpiKV {
    static constexpr bool PERM = true, AFTER_DRAIN = false;
    const float* sskv; bf16_t* KN; bf16_t* V; float epsv;
    __device__ __forceinline__ void operator()(const f32x4 (&acc)[2][2][4][2], const Unit& u, int wr, int wc, int fr, int fq) const {
        bf16_t* base = u.pn < 2 ? KN + u.pn * 256 : V + (u.pn - 2) * 256;
        EPI_ROWS_BEGIN
            const f32x4 sa = *(const f32x4*)(sskv + row * 4);
            const float rs = rsqrtf(((sa[0] + sa[1]) + (sa[2] + sa[3])) * (1.0f / KVL) + epsv);
#pragma unroll
            for (int bj = 0; bj < 2; ++bj) { const f32x4 v0 = acc[ai][bj][m][0] * rs, v1 = acc[ai][bj][m][1] * rs;
                *(u32x4*)(base + (unsigned)row * 512 + bj * HALF + wc * 32 + fq * 8) = pack8(v0, v1); }
        EPI_ROWS_END
    }
};
struct EpiState {
    static constexpr bool PERM = true, AFTER_DRAIN = false;
    float* SST;
    __device__ __forceinline__ void operator()(const f32x4 (&acc)[2][2][4][2], const Unit& u, int wr, int wc, int fr, int fq) const {
        EPI_ROWS_BEGIN
            float* p = SST + (unsigned)(u.z * NCHR + row) * 128u + wc * 32 + fq * 8;
            *(f32x4*)p = acc[ai][0][m][0]; *(f32x4*)(p + 4) = acc[ai][0][m][1];
        EPI_ROWS_END
    }
};
struct EpiS5 {
    static constexpr bool PERM = true, AFTER_DRAIN = false;
    bf16_t* Y;
    __device__ __forceinline__ void operator()(const f32x4 (&acc)[2][2][4][2], const Unit& u, int wr, int wc, int fr, int fq) const {
        EPI_ROWS_BEGIN
#pragma unroll
            for (int bj = 0; bj < 2; ++bj) { f32x4 v0 = acc[ai][bj][m][0], v1 = acc[ai][bj][m][1];
#pragma unroll
                for (int j = 0; j < 4; ++j) { v0[j] = gelu_tanh(v0[j]); v1[j] = gelu_tanh(v1[j]); }
                const int c = u.pn * 256 + bj * HALF + wc * 32 + fq * 8; const int t = c >> 4, h0 = c & 15;
                *(u32x4*)(Y + ((unsigned)row * LCH + t) * SSMW + u.z * 16 + h0) = pack8(v0, v1); }
        EPI_ROWS_END
    }
};
struct EpiOatt {
    static constexpr bool PERM = true, AFTER_DRAIN = false;
    const bf16_t* GATES; bf16_t* MERGED;
    __device__ __forceinline__ void operator()(const f32x4 (&acc)[2][2][4][2], const Unit& u, int wr, int wc, int fr, int fq) const {
        EPI_ROWS_BEGIN
#pragma unroll
            for (int bj = 0; bj < 2; ++bj) { const int col = u.pn * 256 + bj * HALF + wc * 32 + fq * 8;
                const u32x4 gw = *(const u32x4*)(GATES + (unsigned)row * 2048 + col);
                f32x4 v0 = acc[ai][bj][m][0], v1 = acc[ai][bj][m][1];
                v0[0] *= bf_lo(gw.x); v0[1] *= bf_hi(gw.x); v0[2] *= bf_lo(gw.y); v0[3] *= bf_hi(gw.y);
                v1[0] *= bf_lo(gw.z); v1[1] *= bf_hi(gw.z); v1[2] *= bf_lo(gw.w); v1[3] *= bf_hi(gw.w);
                *(u32x4*)(MERGED + (unsigned)row * DM + col) = pack8(v0, v1); }
        EPI_ROWS_END
    }
};
struct EpiGlu {
    static constexpr bool PERM = true, AFTER_DRAIN = false;
    const bf16_t* GATES; bf16_t* MERGED;
    __device__ __forceinline__ void operator()(const f32x4 (&acc)[2][2][4][2], const Unit& u, int wr, int wc, int fr, int fq) const {
        EPI_ROWS_BEGIN
#pragma unroll
            for (int bj = 0; bj < 2; ++bj) { const int col = u.pn * 128 + bj * 64 + wc * 16 + fq * 4;
                const u32x2 gw = *(const u32x2*)(GATES + (unsigned)row * 2048 + 1024 + col);
                bf16_t* mp = MERGED + (unsigned)row * DM + col; const u32x2 mw = *(const u32x2*)mp;
                const f32x4 ga = acc[ai][bj][m][0], gb = acc[ai][bj][m][1];
                const float r0 = bf_lo(mw.x) + bf_lo(gw.x) * ga[0] * sigmoid_f(gb[0]), r1 = bf_hi(mw.x) + bf_hi(gw.x) * ga[1] * sigmoid_f(gb[1]);
                const float r2 = bf_lo(mw.y) + bf_lo(gw.y) * ga[2] * sigmoid_f(gb[2]), r3 = bf_hi(mw.y) + bf_hi(gw.y) * ga[3] * sigmoid_f(gb[3]);
                u32x2 o; o.x = cvt_pk_bf16(r0, r1); o.y = cvt_pk_bf16(r2, r3); *(u32x2*)mp = o; }
        EPI_ROWS_END
    }
};
struct EpiYN {
    static constexpr bool PERM = true, AFTER_DRAIN = false;
    bf16_t* XB; float* OUT; const float* gvec; unsigned long long* gran; float* ssx; unsigned epoch; float epsv; LAS float* red;
    __device__ __forceinline__ void operator()(const f32x4 (&acc)[2][2][4][2], const Unit& u, int wr, int wc, int fr, int fq) const {
        const int lane = fr | (fq << 4);
        const unsigned coff = u.pn * 256 + wc * 32 + fq * 8; const unsigned row0 = u.pm * BM + wr * 64 + fr;
        u32x4 xw[4][2];
#pragma unroll
        for (int m = 0; m < 4; ++m)
#pragma unroll
            for (int bj = 0; bj < 2; ++bj) xw[m][bj] = *(const u32x4*)(XB + (row0 + m * 16) * DM + coff + bj * HALF);
        f32x4 g0[2], g1[2];
#pragma unroll
        for (int bj = 0; bj < 2; ++bj) { const float* gp = gvec + coff + bj * HALF; g0[bj] = *(const f32x4*)gp; g1[bj] = *(const f32x4*)(gp + 4); }
        EPI_ROWS_BEGIN
            float ss = 0.f;
#pragma unroll
            for (int bj = 0; bj < 2; ++bj) ss += sumsq8(acc[ai][bj][m][0], acc[ai][bj][m][1]);
            ss += shx(ss, 16, lane); ss += shx(ss, 32, lane);
            if (fq == 0) red[(row - u.pm * BM) * 4 + wc] = ss;
        EPI_ROWS_END
        asm volatile("s_waitcnt lgkmcnt(0)" ::: "memory"); __builtin_amdgcn_s_barrier(); asm volatile("" ::: "memory");
        if (wr == 0 && wc == 0) {
#pragma unroll
            for (int j = 0; j < 4; ++j) { const f32x4 q = *(const LAS f32x4*)(red + (4 * lane + j) * 4); const float t = (q[0] + q[1]) + (q[2] + q[3]);
                __hip_atomic_store(gran + (size_t)u.pn * T_TOK + u.pm * BM + 4 * lane + j, ((unsigned long long)epoch << 32) | (unsigned long long)__float_as_uint(t), __ATOMIC_RELAXED, __HIP_MEMORY_SCOPE_AGENT); }
        }
        unsigned long long gv[2][4];
        { unsigned sp = 0;
          for (;;) { bool ok = true;
#pragma unroll
              for (int ai = 0; ai < 2; ++ai)
#pragma unroll
                  for (int m = 0; m < 4; ++m) { gv[ai][m] = __hip_atomic_load(gran + (size_t)fq * T_TOK + row0 + ai * HALF + m * 16, __ATOMIC_RELAXED, __HIP_MEMORY_SCOPE_AGENT); ok = ok && ((unsigned)(gv[ai][m] >> 32) == epoch); }
              if (__all(ok) || ++sp > (1u << 20)) break;
              __builtin_amdgcn_s_sleep(1); } }
#pragma unroll
        for (int ai = 0; ai < 2; ++ai) {
            if (ai == 1) {
#pragma unroll
                for (int m = 0; m < 4; ++m)
#pragma unroll
                    for (int bj = 0; bj < 2; ++bj) xw[m][bj] = *(const u32x4*)(XB + (row0 + HALF + m * 16) * DM + coff + bj * HALF);
            }
#pragma unroll
            for (int m = 0; m < 4; ++m) { const unsigned row = row0 + ai * HALF + m * 16;
                float tot = __uint_as_float((unsigned)gv[ai][m]); tot += shx(tot, 16, lane); tot += shx(tot, 32, lane);
                const float rs = rsqrtf(tot * (1.0f / DM) + epsv);
                float ss = 0.f;
#pragma unroll
                for (int bj = 0; bj < 2; ++bj) { const unsigned off = row * DM + coff + bj * HALF; const u32x4 x4 = xw[m][bj];
                    f32x4 v0 = acc[ai][bj][m][0] * rs * g0[bj], v1 = acc[ai][bj][m][1] * rs * g1[bj];
                    v0[0] += bf_lo(x4.x); v0[1] += bf_hi(x4.x); v0[2] += bf_lo(x4.y); v0[3] += bf_hi(x4.y); v1[0] += bf_lo(x4.z); v1[1] += bf_hi(x4.z); v1[2] += bf_lo(x4.w); v1[3] += bf_hi(x4.w);
                    ss += sumsq8(v0, v1);
                    if (OUT) { *(f32x4*)(OUT + off) = v0; *(f32x4*)(OUT + off + 4) = v1; } else *(u32x4*)(XB + off) = pack8(v0, v1); }
                ss += shx(ss, 16, lane); ss += shx(ss, 32, lane);
                if (fq == 0) ssx[row * 16 + u.pn * 4 + wc] = ss; }
            asm volatile("" ::: "memory");
        }
    }
};
__device__ __forceinline__ void dpp_shr12(const f32x4 v, f32x4& r1, f32x4& r2) {
    float a0 = 0.f, a1 = 0.f, a2 = 0.f, a3 = 0.f, b0 = 0.f, b1 = 0.f, b2 = 0.f, b3 = 0.f; const float x0 = v[0], x1 = v[1], x2 = v[2], x3 = v[3];
    asm volatile("s_nop 1\n\t"
                 "v_mov_b32_dpp %0, %8 row_shr:1 row_mask:0xf bank_mask:0xf\n\t" "v_mov_b32_dpp %1, %9 row_shr:1 row_mask:0xf bank_mask:0xf\n\t"
                 "v_mov_b32_dpp %2, %10 row_shr:1 row_mask:0xf bank_mask:0xf\n\t" "v_mov_b32_dpp %3, %11 row_shr:1 row_mask:0xf bank_mask:0xf\n\t"
                 "v_mov_b32_dpp %4, %8 row_shr:2 row_mask:0xf bank_mask:0xf\n\t" "v_mov_b32_dpp %5, %9 row_shr:2 row_mask:0xf bank_mask:0xf\n\t"
                 "v_mov_b32_dpp %6, %10 row_shr:2 row_mask:0xf bank_mask:0xf\n\t" "v_mov_b32_dpp %7, %11 row_shr:2 row_mask:0xf bank_mask:0xf"
                 : "+v"(a0), "+v"(a1), "+v"(a2), "+v"(a3), "+v"(b0), "+v"(b1), "+v"(b2), "+v"(b3) : "v"(x0), "v"(x1), "v"(x2), "v"(x3));
    r1 = (f32x4){a0, a1, a2, a3}; r2 = (f32x4){b0, b1, b2, b3};
}
struct EpiUpConv {
    static constexpr bool PERM = true, AFTER_DRAIN = false;
    const float* ssx; float epsv; const float* cw; const float* cb; bf16_t* ACT; float* GL; float* GF; float* VF; LAS float* X;
    __device__ __forceinline__ void operator()(const f32x4 (&acc)[2][2][4][2], const Unit& u, int wr, int wc, int fr, int fq) const {
        const int lane = fr | (fq << 4);
        const unsigned oc0 = u.pn * 128 + wc * 16 + fq * 4;
        float rsv[2][4];
#pragma unroll
        for (int ai = 0; ai < 2; ++ai)
#pragma unroll
            for (int m = 0; m < 4; ++m) rsv[ai][m] = row_rstd(ssx, u.pm * BM + ai * HALF + wr * 64 + m * 16 + fr, epsv, lane, fq);
        if (fr >= 14) {
#pragma unroll
            for (int ai = 0; ai < 2; ++ai)
#pragma unroll
                for (int m = 0; m < 4; ++m) { const int gidx = ai * 8 + wr * 4 + m;
#pragma unroll
                    for (int bj = 0; bj < 2; ++bj) { const f32x4 cur = acc[ai][bj][m][0] * rsv[ai][m];
                        *(LAS f32x4*)(X + ((((gidx * 4 + wc) * 2 + bj) * 2 + (fr - 14)) * 4 + fq) * 4) = cur;
                        if (gidx == 15) *(f32x4*)(GL + (size_t)(u.pm * 2 + (fr - 14)) * DFF + oc0 + bj * 64) = cur; } }
        }
        f32x4 w0[2], w1[2], w2[2], bb[2];
#pragma unroll
        for (int bj = 0; bj < 2; ++bj) { const unsigned oc = oc0 + bj * 64; w0[bj] = *(const f32x4*)(cw + oc); w1[bj] = *(const f32x4*)(cw + DFF + oc); w2[bj] = *(const f32x4*)(cw + 2 * DFF + oc); bb[bj] = *(const f32x4*)(cb + oc); }
        asm volatile("s_waitcnt lgkmcnt(0)" ::: "memory"); __builtin_amdgcn_s_barrier(); asm volatile("" ::: "memory");
#pragma unroll
        for (int ai = 0; ai < 2; ++ai)
#pragma unroll
            for (int m = 0; m < 4; ++m) { const int gidx = ai * 8 + wr * 4 + m; const unsigned row = u.pm * BM + ai * HALF + wr * 64 + m * 16 + fr; const float rs = rsv[ai][m];
#pragma unroll
                for (int bj = 0; bj < 2; ++bj) { const unsigned oc = oc0 + bj * 64;
                    const f32x4 cur = acc[ai][bj][m][0] * rs, val = acc[ai][bj][m][1] * rs;
                    f32x4 g1, g2; dpp_shr12(cur, g1, g2);
                    if (fr < 2) {
                        f32x4 x14 = {0.f, 0.f, 0.f, 0.f}, x15 = x14;
                        if (gidx > 0) { const LAS float* xp = X + (((((gidx - 1) * 4 + wc) * 2 + bj) * 2) * 4 + fq) * 4; x14 = *(const LAS f32x4*)xp; x15 = *(const LAS f32x4*)(xp + 16); }
                        if (fr == 0) { g1 = x15; g2 = x14; } else g2 = x15;
                        if (gidx == 0) { *(f32x4*)(GF + (size_t)(u.pm * 2 + fr) * DFF + oc) = cur; *(f32x4*)(VF + (size_t)(u.pm * 2 + fr) * DFF + oc) = val; }
                    }
                    const f32x4 cv = bb[bj] + w0[bj] * g2 + w1[bj] * g1 + w2[bj] * cur;
                    f32x4 o;
#pragma unroll
                    for (int j = 0; j < 4; ++j) o[j] = gelu_tanh(cv[j]) * val[j];
                    u32x2 w; w.x = cvt_pk_bf16(o[0], o[1]); w.y = cvt_pk_bf16(o[2], o[3]);
                    *(u32x2*)(ACT + row * DFF + oc) = w; }
            }
    }
};

struct Args { const float* in[26]; float* out; unsigned char* ws; int ph_lo, ph_hi; };
struct Ctx { unsigned char* ws; const long long* dl; float* out;
    __device__ __forceinline__ const float* inp(int i) const { return (const float*)(ws + dl[i]); } };

enum { I_X = 0, I_WIN, I_BGATE, I_GMIXPRE, I_GQ, I_WUQ, I_GKV, I_WUKV, I_WOATT, I_LAMRE, I_LAMIM, I_LOGSTEP, I_BRE, I_BIM, I_CRE, I_CIM, I_DSKIP, I_WGLU, I_WOUT, I_GMIXPOST, I_GFFNPRE, I_WUP, I_CONVW, I_CONVB, I_WDOWN, I_GFFNPOST };

__device__ __forceinline__ float wave_sum(float v, int lane) {
#pragma unroll
    for (int o = 1; o < 64; o <<= 1) v += shx(v, o, lane);
    return v;
}

__device__ __forceinline__ int rope_sigma(int c) { return 4 * (c >> 3) + (c & 3) + 16 * ((c >> 2) & 1); }
__device__ __forceinline__ int src_col(int kind, int n) {
    if (kind == 0) {
        if (n < 384) return n;
        if (n < 416) return 640 + rope_sigma(n - 384);
        if (n < 512) return -1;
        if (n < 768) return 384 + (n - 512);
        if (n < 1280) return 672 + (n - 768);
        return 1184 + (n - 1280);
    } else if (kind == 1) {
        const int h = n / 96, c = n % 96; return c < 64 ? n : h * 96 + 64 + rope_sigma(c - 64);
    } else if (kind == 2) {
        const int hh = (n & 511) >> 6, d = n & 63; return hh * 128 + (n >= 512 ? 64 : 0) + d;
    } else if (kind == 3) {
        const int q = n >> 3, nn = (n >> 2) & 1, j = n & 3; return nn * 1024 + 4 * q + j;
    } else if (kind == 5) {
        const int q = n >> 3, nn = (n >> 2) & 1, j = n & 3; return nn * DFF + 4 * q + j;
    }
    return n;
}
__device__ __forceinline__ void transpose_item(int kind, const float* W, int K, int Nsrc, bf16_t* WT, const float* gk, LAS float* scr, int item, int nblk, int lane) {
    const int kb = item / nblk, nb = item % nblk, k0 = 64 * kb, n0 = 32 * nb;
    const int src = src_col(kind, n0 + (lane & 31));
    float v[32];
    const float* wp = W + (size_t)(k0 + (lane >> 5)) * Nsrc + (src >= 0 ? src : 0);
#pragma unroll
    for (int i = 0; i < 32; ++i) v[i] = wp[(size_t)(2 * i) * Nsrc];
    if (src < 0) {
#pragma unroll
        for (int i = 0; i < 32; ++i) v[i] = 0.f;
    }
    if (gk) {
#pragma unroll
        for (int i = 0; i < 32; ++i) v[i] *= gk[k0 + 2 * i + (lane >> 5)];
    }
#pragma unroll
    for (int i = 0; i < 32; ++i) scr[(2 * i + (lane >> 5)) * 33 + (lane & 31)] = v[i];
    asm volatile("s_waitcnt lgkmcnt(0)" ::: "memory");
    const int c = lane & 7;
#pragma unroll
    for (int j = 0; j < 4; ++j) { const int n = (lane >> 3) + 8 * j; const LAS float* s = scr + (8 * c) * 33 + n;
        u32x4 o; o.x = cvt_pk_bf16(s[0 * 33], s[1 * 33]); o.y = cvt_pk_bf16(s[2 * 33], s[3 * 33]); o.z = cvt_pk_bf16(s[4 * 33], s[5 * 33]); o.w = cvt_pk_bf16(s[6 * 33], s[7 * 33]);
        *(u32x4*)(WT + (size_t)(n0 + n) * K + k0 + 8 * c) = o; }
    asm volatile("s_waitcnt lgkmcnt(0)" ::: "memory");
}

__device__ __forceinline__ void sincos_red(float x, float& sn, float& cs) {
    const float k = rintf(x * 0.15915494309189535f);
    float r = fmaf(-k, 6.28125f, x); r = fmaf(-k, 1.9353071795864769e-3f, r);
    sn = __sinf(r); cs = __cosf(r);
}
__device__ __forceinline__ void s5_prep_item(const Ctx& a, int l, int g, int qt, LAS unsigned char* lds, int tid) {
    constexpr int PS = 65;
    LAS float* pr = (LAS float*)lds; LAS float* pi = pr + 2176; LAS float* bbr = pi + 2176; LAS float* bbi = bbr + 1024;
    LAS float* crT = bbi + 1024; LAS float* ciT = crT + 1024; LAS float* Kt = ciT + 1024; LAS float* frv = Kt + 8192; LAS float* fiv = frv + 64;
    const int lg = l * NGRP + g;
    const float delta = __expf(a.inp(I_LOGSTEP)[lg]);
    for (int idx = tid; idx < 33 * 64; idx += 512) { const int tau = idx >> 6, p = idx & 63;
        const float lr = a.inp(I_LAMRE)[lg * 64 + p], li = a.inp(I_LAMIM)[lg * 64 + p];
        const float mag = __expf(lr * delta * (float)tau);
        float sn, cs; sincos_red(li * delta * (float)tau, sn, cs);
        pr[tau * PS + p] = mag * cs; pi[tau * PS + p] = mag * sn; }
    for (int idx = tid; idx < 1024; idx += 512) { const int h = idx >> 6, p = idx & 63; crT[p * 16 + h] = a.inp(I_CRE)[(size_t)lg * 1024 + idx]; ciT[p * 16 + h] = a.inp(I_CIM)[(size_t)lg * 1024 + idx]; }
    if (tid < 64) { const int p = tid;
        const float lr = a.inp(I_LAMRE)[lg * 64 + p], li = a.inp(I_LAMIM)[lg * 64 + p];
        const float xe = lr * delta; const float em = xe * (1.0f + xe * (0.5f + xe * (0.16666667f + xe * (0.041666668f + xe * 0.0083333338f))));
        float sn, cs, sh, ch; sincos_red(li * delta, sn, cs); sincos_red(0.5f * li * delta, sh, ch);
        const float nr = em * cs - 2.0f * sh * sh, ni = (1.0f + em) * sn, den = lr * lr + li * li;
        frv[p] = (nr * lr + ni * li) / den; fiv[p] = (ni * lr - nr * li) / den; }
    __syncthreads();
    if (qt == 0 && tid < 64) { float* AL = (float*)(a.ws + OFF_AL); AL[(g * 64 + tid) * 2] = pr[32 * PS + tid]; AL[(g * 64 + tid) * 2 + 1] = pi[32 * PS + tid]; }
    for (int idx = tid; idx < 1024; idx += 512) { const int p = idx >> 4;
        const float br = a.inp(I_BRE)[(size_t)lg * 1024 + idx], bi = a.inp(I_BIM)[(size_t)lg * 1024 + idx];
        bbr[idx] = frv[p] * br - fiv[p] * bi; bbi[idx] = frv[p] * bi + fiv[p] * br; }
    __syncthreads();
    {
        const int tau = tid >> 4, h = tid & 15;
        f32x4 s0 = {0.f, 0.f, 0.f, 0.f}, s1 = s0, s2 = s0, s3 = s0;
        for (int p = 0; p < 64; ++p) { const float c_r = crT[p * 16 + h], c_i = ciT[p * 16 + h], a_r = pr[tau * PS + p], a_i = pi[tau * PS + p];
            const float car = c_r * a_r - c_i * a_i, cai = c_r * a_i + c_i * a_r;
            const LAS f32x4* br4 = (const LAS f32x4*)(bbr + p * 16); const LAS f32x4* bi4 = (const LAS f32x4*)(bbi + p * 16);
            s0 += car * br4[0] - cai * bi4[0]; s1 += car * br4[1] - cai * bi4[1]; s2 += car * br4[2] - cai * bi4[2]; s3 += car * br4[3] - cai * bi4[3]; }
        if (tau == 0) { const float dd = a.inp(I_DSKIP)[l * SSMW + g * 16 + h];
            if ((h >> 2) == 0) s0[h & 3] += dd; else if ((h >> 2) == 1) s1[h & 3] += dd; else if ((h >> 2) == 2) s2[h & 3] += dd; else s3[h & 3] += dd; }
        LAS f32x4* kp = (LAS f32x4*)(Kt + tau * 256 + h * 16); kp[0] = s0; kp[1] = s1; kp[2] = s2; kp[3] = s3;
    }
    __syncthreads();
    bf16_t* TVg = (bf16_t*)(a.ws + WS_W) + WE_TV + (size_t)g * 512 * KS5;
    for (int it = tid; it < 128 * 80; it += 512) { const int n = 128 * qt + it / 80, kc = it % 80, t = n >> 4, h = n & 15; float v[8];
        if (kc < 64) { const int s = kc >> 1, hp0 = (kc & 1) * 8;
#pragma unroll
            for (int j = 0; j < 8; ++j) v[j] = (s <= t) ? Kt[((t - s) & 31) * 256 + h * 16 + hp0 + j] : 0.f;
        } else if (kc < 72) { const int p0 = (kc - 64) * 8;
#pragma unroll
            for (int j = 0; j < 8; ++j) { const int p = p0 + j; v[j] = crT[p * 16 + h] * pr[(t + 1) * PS + p] - ciT[p * 16 + h] * pi[(t + 1) * PS + p]; }
        } else { const int p0 = (kc - 72) * 8;
#pragma unroll
            for (int j = 0; j < 8; ++j) { const int p = p0 + j; v[j] = -(crT[p * 16 + h] * pi[(t + 1) * PS + p] + ciT[p * 16 + h] * pr[(t + 1) * PS + p]); }
        }
        u32x4 o; o.x = cvt_pk_bf16(v[0], v[1]); o.y = cvt_pk_bf16(v[2], v[3]); o.z = cvt_pk_bf16(v[4], v[5]); o.w = cvt_pk_bf16(v[6], v[7]);
        *(u32x4*)(TVg + (size_t)n * KS5 + kc * 8) = o; }
    bf16_t* Wg = (bf16_t*)(a.ws + WS_W) + WE_WST + (size_t)g * 256 * 512;
    for (int it = tid; it < 64 * 64; it += 512) { const int n = 64 * qt + (it >> 6), kc = it & 63, s = kc >> 1, hp0 = (kc & 1) * 8, tau = 31 - s; float v[8];
        if (n < 64) { const int p = n;
#pragma unroll
            for (int j = 0; j < 8; ++j) v[j] = pr[tau * PS + p] * bbr[p * 16 + hp0 + j] - pi[tau * PS + p] * bbi[p * 16 + hp0 + j];
        } else if (n < 128) { const int p = n - 64;
#pragma unroll
            for (int j = 0; j < 8; ++j) v[j] = pr[tau * PS + p] * bbi[p * 16 + hp0 + j] + pi[tau * PS + p] * bbr[p * 16 + hp0 + j];
        } else {
#pragma unroll
            for (int j = 0; j < 8; ++j) v[j] = 0.f;
        }
        u32x4 o; o.x = cvt_pk_bf16(v[0], v[1]); o.y = cvt_pk_bf16(v[2], v[3]); o.z = cvt_pk_bf16(v[4], v[5]); o.w = cvt_pk_bf16(v[6], v[7]);
        *(u32x4*)(Wg + (size_t)n * 512 + kc * 8) = o; }
    __syncthreads();
}

__device__ __forceinline__ void prep_layer(const Ctx& a, int l, LAS unsigned char* lds, int tid, int wid, int lane, int G, int cu, int part) {
    if (part == 0) for (int it = cu; it < NGRP * 4; it += G) s5_prep_item(a, l, it >> 2, it & 3, lds, tid);
    __syncthreads();
    LAS float* scr = (LAS float*)(lds + wid * 16384);
    bf16_t* Wb = (bf16_t*)(a.ws + WS_W);
    constexpr int N_IN = 16 * 104, N_UQ = 6 * 24, N_UKV = 4 * 32, N_OATT = 8 * 32, N_GLU = 8 * 64, N_OUT = 16 * 32, N_UP = 16 * 176, N_DOWN = 44 * 32;
    constexpr int NITEMS = N_IN + N_UQ + N_UKV + N_OATT + N_GLU + N_OUT + N_UP + N_DOWN;
    constexpr int N_MIX = N_IN + N_UQ + N_UKV + N_OATT + N_GLU + N_OUT;
    const int gw = part == 0 ? ((cu + G / 2) % G) * 8 + wid : N_MIX + (cu - G / 2) * 8 + wid;
    const int NGW = part == 0 ? G * 8 : (G - G / 2) * 8, iend = part == 0 ? N_MIX : NITEMS;
    for (int it = gw; it < iend; it += NGW) { int r = it, kind, si, gi, K, Nsrc, nblk; size_t lstride, doff;
        if (r < N_IN) { kind = 0; si = I_WIN; gi = I_GMIXPRE; K = DM; Nsrc = INC; nblk = 104; lstride = (size_t)DM * INC; doff = WE_IN; }
        else if ((r -= N_IN) < N_UQ) { kind = 1; si = I_WUQ; gi = I_GQ; K = QL; Nsrc = 768; nblk = 24; lstride = (size_t)QL * 768; doff = WE_UQ; }
        else if ((r -= N_UQ) < N_UKV) { kind = 2; si = I_WUKV; gi = I_GKV; K = KVL; Nsrc = 1024; nblk = 32; lstride = (size_t)KVL * 1024; doff = WE_UKV; }
        else if ((r -= N_UKV) < N_OATT) { kind = 4; si = I_WOATT; gi = -1; K = 512; Nsrc = DM; nblk = 32; lstride = (size_t)512 * DM; doff = WE_OATT; }
        else if ((r -= N_OATT) < N_GLU) { kind = 3; si = I_WGLU; gi = -1; K = SSMW; Nsrc = 2048; nblk = 64; lstride = (size_t)SSMW * 2048; doff = WE_GLU; }
        else if ((r -= N_GLU) < N_OUT) { kind = 4; si = I_WOUT; gi = -1; K = DM; Nsrc = DM; nblk = 32; lstride = (size_t)DM * DM; doff = WE_OUT; }
        else if ((r -= N_OUT) < N_UP) { kind = 5; si = I_WUP; gi = I_GFFNPRE; K = DM; Nsrc = 2 * DFF; nblk = 176; lstride = (size_t)DM * 2 * DFF; doff = WE_UP; }
        else { r -= N_UP; kind = 4; si = I_WDOWN; gi = -1; K = DFF; Nsrc = DM; nblk = 32; lstride = (size_t)DFF * DM; doff = WE_DOWN; }
        const float* W = a.inp(si) + (size_t)l * lstride; const float* gk = gi >= 0 ? a.inp(gi) + (size_t)l * K : nullptr;
        transpose_item(kind, W, K, Nsrc, Wb + doff, gk, scr, r, nblk, lane);
    }
    __syncthreads();
}

__device__ __forceinline__ void init_phase(const Ctx& a, int tid, int wid, int lane, int G, int cu, float epsv) {
    const int gw = cu * 8 + wid, NGW = G * 8;
    bf16_t* XB = (bf16_t*)(a.ws + WS_XY); float* ssx = (float*)(a.ws + WS_SSX);
    for (int row = gw; row < T_TOK; row += NGW) {
        const f32x4* xr = (const f32x4*)(a.inp(I_X) + (size_t)row * DM) + lane; u32x2* bo = (u32x2*)(XB + (size_t)row * DM) + lane;
        float ss = 0.f;
#pragma unroll
        for (int j = 0; j < 4; ++j) { const f32x4 v = xr[64 * j]; ss += (v[0] * v[0] + v[1] * v[1]) + (v[2] * v[2] + v[3] * v[3]);
            u32x2 w; w.x = cvt_pk_bf16(v[0], v[1]); w.y = cvt_pk_bf16(v[2], v[3]); bo[64 * j] = w; }
        ss = wave_sum(ss, lane);
        if (lane < 16) ssx[row * 16 + lane] = lane == 0 ? ss : 0.f;
    }
    const int gt = cu * 512 + tid, NT = G * 512;
    float* rope = (float*)(a.ws + OFF_ROPE);
    for (int i = gt; i < SEQ * 16; i += NT) { const int pos = i >> 4, k = i & 15;
        const float inv = exp2f(-(float)k * 0.83048202372184058696f);
        float sn, cs; sincos_red((float)pos * inv, sn, cs);
        rope[2 * i] = cs; rope[2 * i + 1] = sn; }
}

__device__ __forceinline__ void normres_phase(const Ctx& a, const float* gvec, const float* ssy, int tid, int wid, int lane, int G, int cu, float epsv, bool final_out) {
    const int gw = cu * 8 + wid, NGW = G * 8;
    float* X = a.out; bf16_t* XB = (bf16_t*)(a.ws + WS_XY); const bf16_t* YB = (const bf16_t*)(a.ws + WS_YB); float* rstdx = (float*)(a.ws + OFF_RSTDX);
    f32x4 gv[4];
#pragma unroll
    for (int j = 0; j < 4; ++j) gv[j] = ((const f32x4*)gvec)[lane + 64 * j];
    for (int row0 = gw * 4; row0 < T_TOK; row0 += NGW * 4) {
        u32x2 xw[4][4], yw[4][4]; float rs[4];
#pragma unroll
        for (int r = 0; r < 4; ++r) { const int row = row0 + r;
            const u32x2* xp = (const u32x2*)(XB + (size_t)row * DM) + lane; const u32x2* yp = (const u32x2*)(YB + (size_t)row * DM) + lane;
#pragma unroll
            for (int j = 0; j < 4; ++j) { xw[r][j] = xp[64 * j]; yw[r][j] = yp[64 * j]; }
            rs[r] = ssy[row * 16 + (lane & 15)]; }
#pragma unroll
        for (int r = 0; r < 4; ++r) { const int row = row0 + r;
            float sp_ = rs[r];
            sp_ += shx(sp_, 1, lane); sp_ += shx(sp_, 2, lane); sp_ += shx(sp_, 4, lane); sp_ += shx(sp_, 8, lane);
            const float rsv = rsqrtf(sp_ * (1.0f / DM) + epsv);
            u32x2* xp = (u32x2*)(XB + (size_t)row * DM) + lane; f32x4* op = (f32x4*)(X + (size_t)row * DM) + lane;
            float ss = 0.f;
#pragma unroll
            for (int j = 0; j < 4; ++j) { const u32x2 x2 = xw[r][j], y2 = yw[r][j]; f32x4 v;
                v[0] = bf_lo(x2.x) + bf_lo(y2.x) * rsv * gv[j][0]; v[1] = bf_hi(x2.x) + bf_hi(y2.x) * rsv * gv[j][1]; v[2] = bf_lo(x2.y) + bf_lo(y2.y) * rsv * gv[j][2]; v[3] = bf_hi(x2.y) + bf_hi(y2.y) * rsv * gv[j][3];
                ss += (v[0] * v[0] + v[1] * v[1]) + (v[2] * v[2] + v[3] * v[3]);
                if (final_out) op[64 * j] = v;
                else { u32x2 w; w.x = cvt_pk_bf16(v[0], v[1]); w.y = cvt_pk_bf16(v[2], v[3]); xp[64 * j] = w; } }
            ss = wave_sum(ss, lane);
            if (lane == 0) rstdx[row] = rsqrtf(ss * (1.0f / DM) + epsv);
        }
    }
}

__device__ __forceinline__ void conv_fixup_phase(const Ctx& a, int l, int tid, int G, int cu) {
    const int gt = cu * 512 + tid, NT = G * 512;
    const float* GL = (const float*)(a.ws + WS_GL); const float* GF = (const float*)(a.ws + WS_GF); const float* VF = (const float*)(a.ws + WS_VF); bf16_t* ACT = (bf16_t*)(a.ws + WS_VAL);
    const float* cw = a.inp(I_CONVW) + (size_t)l * 3 * DFF; const float* cb = a.inp(I_CONVB) + (size_t)l * DFF;
    constexpr int NC4 = DFF / 4;
    for (int it = gt; it < (T_TOK / BM) * NC4; it += NT) { const int pm = it / NC4, oc = (it - pm * NC4) * 4;
        const f32x4 z = {0.f, 0.f, 0.f, 0.f};
        const bool first = (pm & (SEQ / BM - 1)) == 0;
        const f32x4 p14 = first ? z : *(const f32x4*)(GL + (size_t)((pm - 1) * 2 + 0) * DFF + oc), p15 = first ? z : *(const f32x4*)(GL + (size_t)((pm - 1) * 2 + 1) * DFF + oc);
        const f32x4 c0 = *(const f32x4*)(GF + (size_t)(pm * 2 + 0) * DFF + oc), c1 = *(const f32x4*)(GF + (size_t)(pm * 2 + 1) * DFF + oc);
        const f32x4 v0 = *(const f32x4*)(VF + (size_t)(pm * 2 + 0) * DFF + oc), v1 = *(const f32x4*)(VF + (size_t)(pm * 2 + 1) * DFF + oc);
        const f32x4 w0 = *(const f32x4*)(cw + oc), w1 = *(const f32x4*)(cw + DFF + oc), w2 = *(const f32x4*)(cw + 2 * DFF + oc), bb = *(const f32x4*)(cb + oc);
        const f32x4 cv0 = bb + w0 * p14 + w1 * p15 + w2 * c0, cv1 = bb + w0 * p15 + w1 * c0 + w2 * c1;
        f32x4 o0, o1;
#pragma unroll
        for (int j = 0; j < 4; ++j) { o0[j] = gelu_tanh(cv0[j]) * v0[j]; o1[j] = gelu_tanh(cv1[j]) * v1[j]; }
        u32x2 w; w.x = cvt_pk_bf16(o0[0], o0[1]); w.y = cvt_pk_bf16(o0[2], o0[3]); *(u32x2*)(ACT + (size_t)(pm * BM) * DFF + oc) = w;
        w.x = cvt_pk_bf16(o1[0], o1[1]); w.y = cvt_pk_bf16(o1[2], o1[3]); *(u32x2*)(ACT + (size_t)(pm * BM + 1) * DFF + oc) = w;
    }
}

__device__ __forceinline__ void carry_phase(const Ctx& a, int tid, int G, int cu) {
    const float* AL = (const float*)(a.ws + OFF_AL); const float* SST = (const float*)(a.ws + WS_SST); bf16_t* UP = (bf16_t*)(a.ws + WS_UP);
    if (tid < 128)
    for (int idx = cu * 128 + tid; idx < NBATCH * NGRP * NST; idx += G * 128) { const int p = idx & 63, g = (idx >> 6) & 31, b = idx >> 11;
        const float alr = AL[(g * 64 + p) * 2], ali = AL[(g * 64 + p) * 2 + 1]; float sr = 0.f, si = 0.f;
        const size_t R0 = (size_t)g * NCHR + b * (SEQ / LCH);
#pragma unroll
        for (int h = 0; h < 2; ++h) {
            float xr[32], xi[32];
#pragma unroll
            for (int c = 0; c < 32; ++c) { xr[c] = SST[(R0 + h * 32 + c) * 128 + p]; xi[c] = SST[(R0 + h * 32 + c) * 128 + 64 + p]; }
#pragma unroll
            for (int c = 0; c < 32; ++c) { const size_t R = R0 + h * 32 + c;
                UP[R * KS5 + 512 + p] = (bf16_t)(cvt_pk_bf16(sr, 0.f) & 0xffffu); UP[R * KS5 + 576 + p] = (bf16_t)(cvt_pk_bf16(si, 0.f) & 0xffffu);
                const float nr = alr * sr - ali * si + xr[c], ni = alr * si + ali * sr + xi[c]; sr = nr; si = ni; }
        }
    }
}

typedef __attribute__((address_space(3))) const char* lds_cptr;
typedef short v4i16_t __attribute__((ext_vector_type(4)));
__device__ __forceinline__ s16x4 vtr(lds_cptr p) { return __builtin_bit_cast(s16x4, __builtin_amdgcn_ds_read_tr16_b64_v4i16((__attribute__((address_space(3))) v4i16_t*)p)); }

__device__ __forceinline__ float quad_max(float x) {
    float p = x, q = x; asm volatile("s_nop 1\n\tv_permlane32_swap_b32 %0, %1" : "+v"(p), "+v"(q));
    float m = fmaxf(p, q); p = m; q = m; asm volatile("s_nop 1\n\tv_permlane16_swap_b32 %0, %1" : "+v"(p), "+v"(q));
    return fmaxf(p, q);
}
__device__ __forceinline__ float quad_sum(float x) {
    float p = x, q = x; asm volatile("s_nop 1\n\tv_permlane32_swap_b32 %0, %1" : "+v"(p), "+v"(q));
    float m = p + q; p = m; q = m; asm volatile("s_nop 1\n\tv_permlane16_swap_b32 %0, %1" : "+v"(p), "+v"(q));
    return p + q;
}
__device__ __forceinline__ void attn_tile(LAS unsigned char* Kb, LAS unsigned char* Vb, const bf16x8 (&qf)[2][3], f32x4 (&o)[4][2], float (&mrun)[2], float (&lrun)[2], int l15, int quad, int lane) {
            f32x4 s[4][2];
            bf16x8 kf[4][3];
#pragma unroll
            for (int kb = 0; kb < 4; ++kb)
#pragma unroll
                for (int dc = 0; dc < 3; ++dc) kf[kb][dc] = *(const LAS bf16x8*)(Kb + (kb * 16 + l15) * 256 + (((dc * 4 + quad) ^ l15) << 4));
            __builtin_amdgcn_sched_barrier(0);
#pragma unroll
            for (int kb = 0; kb < 4; ++kb) {
#pragma unroll
                for (int dc = 0; dc < 3; ++dc) {
#pragma unroll
                    for (int qk = 0; qk < 2; ++qk) s[kb][qk] = __builtin_amdgcn_mfma_f32_16x16x32_bf16(kf[kb][dc], qf[qk][dc], dc == 0 ? (f32x4){0.f, 0.f, 0.f, 0.f} : s[kb][qk], 0, 0, 0); }
            }
            s16x4 vlo[2][4], vhi[2][4];
#pragma unroll
            for (int kk = 0; kk < 2; ++kk)
#pragma unroll
                for (int d = 0; d < 4; ++d) { const lds_cptr vp = (lds_cptr)(Vb + (32 * kk + 4 * quad + (l15 >> 2)) * 160 + (16 * d + 4 * (lane & 3)) * 2); vlo[kk][d] = vtr(vp); vhi[kk][d] = vtr(vp + 16 * 160); }
            __builtin_amdgcn_sched_barrier(0);
            float mx2[2];
#pragma unroll
            for (int qk = 0; qk < 2; ++qk) {
                float mx = s[0][qk][0];
#pragma unroll
                for (int kb = 0; kb < 4; ++kb)
#pragma unroll
                    for (int j = 0; j < 4; ++j) mx = fmaxf(mx, s[kb][qk][j]);
                mx2[qk] = quad_max(mx); }
            if (!__all((mx2[0] - mrun[0] <= 8.0f) && (mx2[1] - mrun[1] <= 8.0f))) {
#pragma unroll
                for (int qk = 0; qk < 2; ++qk) { const float mn = fmaxf(mrun[qk], mx2[qk]), alpha = __builtin_amdgcn_exp2f(mrun[qk] - mn); mrun[qk] = mn; lrun[qk] *= alpha;
#pragma unroll
                    for (int d = 0; d < 4; ++d) o[d][qk] = o[d][qk] * alpha; }
            }
#pragma unroll
            for (int qk = 0; qk < 2; ++qk) { const float mn = mrun[qk]; float rsum = 0.f;
#pragma unroll
                for (int kb = 0; kb < 4; ++kb)
#pragma unroll
                    for (int j = 0; j < 4; ++j) { const float p = __builtin_amdgcn_exp2f(s[kb][qk][j] - mn); rsum += p; s[kb][qk][j] = p; }
                lrun[qk] += rsum; }
#pragma unroll
            for (int kk = 0; kk < 2; ++kk) {
                bf16x8 pf[2];
#pragma unroll
                for (int qk = 0; qk < 2; ++qk) { const u32x4 w = pack8(s[2 * kk][qk], s[2 * kk + 1][qk]); pf[qk] = __builtin_bit_cast(bf16x8, w); }
#pragma unroll
                for (int d = 0; d < 4; ++d) {
                    const s16x4 lo = vlo[kk][d], hi = vhi[kk][d];
                    const bf16x8 vf = (bf16x8){lo[0], lo[1], lo[2], lo[3], hi[0], hi[1], hi[2], hi[3]};
#pragma unroll
                    for (int qk = 0; qk < 2; ++qk) o[d][qk] = __builtin_amdgcn_mfma_f32_16x16x32_bf16(vf, pf[qk], o[d][qk], 0, 0, 0);
                }
            }
}
__device__ __forceinline__ void attn_unit(const Ctx& a, LAS unsigned char* lds, int b, int h, int qb, int tid, int wid, int lane) {
    const bf16_t* Q = (const bf16_t*)(a.ws + WS_Q); const bf16_t* KN = (const bf16_t*)(a.ws + WS_KN); const bf16_t* KPE = (const bf16_t*)(a.ws + WS_KPE);
    const bf16_t* V = (const bf16_t*)(a.ws + WS_V); bf16_t* O = (bf16_t*)(a.ws + WS_O);
    const int l15 = lane & 15, quad = lane >> 4;
    const int ntile = 4 * qb + 4, cw = 4 * qb + (wid >> 1);
    const size_t tok0 = (size_t)b * SEQ;
    bf16x8 qf[2][3];
#pragma unroll
    for (int qk = 0; qk < 2; ++qk)
#pragma unroll
        for (int dc = 0; dc < 3; ++dc) qf[qk][dc] = *(const bf16x8*)(Q + (tok0 + qb * 256 + wid * 32 + qk * 16 + l15) * 768 + h * QKD + dc * 32 + quad * 8);
    f32x4 o[4][2];
#pragma unroll
    for (int d = 0; d < 4; ++d) { o[d][0] = (f32x4){0.f, 0.f, 0.f, 0.f}; o[d][1] = (f32x4){0.f, 0.f, 0.f, 0.f}; }
    float mrun[2] = {-INFINITY, -INFINITY}, lrun[2] = {0.f, 0.f};
    const int kkey = tid >> 3, kch = tid & 7;
    const int pkey = (tid >> 2) & 63, pch = 8 + (tid & 3);
    const unsigned k_lds = kkey * 256 + ((kch ^ (kkey & 15)) << 4), p_lds = pkey * 256 + ((pch ^ (pkey & 15)) << 4), v_lds = kkey * 160 + kch * 16;
    const bf16_t* gk = KN + (tok0 + kkey) * 512 + h * 64 + kch * 8; const bf16_t* gp = KPE + (tok0 + pkey) * ROPE_D + (tid & 3) * 8; const bf16_t* gv = V + (tok0 + kkey) * 512 + h * 64 + kch * 8;
    const bool ppe = tid < 256;
    u32x4 r0k = *(const u32x4*)gk, r0v = *(const u32x4*)gv, r0p = (u32x4){0u, 0u, 0u, 0u};
    if (ppe) r0p = *(const u32x4*)gp;
    u32x4 r1k = *(const u32x4*)(gk + (size_t)64 * 512), r1v = *(const u32x4*)(gv + (size_t)64 * 512), r1p = (u32x4){0u, 0u, 0u, 0u};
    if (ppe) r1p = *(const u32x4*)(gp + (size_t)64 * ROPE_D);
    *(LAS u32x4*)(lds + k_lds) = r0k; *(LAS u32x4*)(lds + 32768 + v_lds) = r0v; if (ppe) *(LAS u32x4*)(lds + p_lds) = r0p;
    __syncthreads();
#define ATT_STEP(KT, RAk, RAv, RAp, RBk, RBv, RBp) { const int kt_ = (KT); \
        if (kt_ + 2 < ntile) { const size_t adv = (size_t)(kt_ + 2) * 64; RAk = *(const u32x4*)(gk + adv * 512); RAv = *(const u32x4*)(gv + adv * 512); if (ppe) RAp = *(const u32x4*)(gp + adv * ROPE_D); } \
        if (kt_ <= cw) attn_tile(lds + (kt_ & 1) * 16384, lds + 32768 + (kt_ & 1) * 10240, qf, o, mrun, lrun, l15, quad, lane); \
        if (kt_ + 1 < ntile) { const int nb = (kt_ + 1) & 1; \
            *(LAS u32x4*)(lds + nb * 16384 + k_lds) = RBk; *(LAS u32x4*)(lds + 32768 + nb * 10240 + v_lds) = RBv; if (ppe) *(LAS u32x4*)(lds + nb * 16384 + p_lds) = RBp; } \
        __syncthreads(); }
    for (int kt = 0; kt < ntile; kt += 2) {
        ATT_STEP(kt, r0k, r0v, r0p, r1k, r1v, r1p)
        ATT_STEP(kt + 1, r1k, r1v, r1p, r0k, r0v, r0p)
    }
#undef ATT_STEP
#pragma unroll
    for (int qk = 0; qk < 2; ++qk) { const float lt = quad_sum(lrun[qk]); const float inv = 1.0f / lt;
        bf16_t* op = O + (tok0 + qb * 256 + wid * 32 + qk * 16 + l15) * 512 + h * 64 + 4 * quad;
#pragma unroll
        for (int d = 0; d < 4; ++d) { const f32x4 v = o[d][qk] * inv; u32x2 w; w.x = cvt_pk_bf16(v[0], v[1]); w.y = cvt_pk_bf16(v[2], v[3]); *(u32x2*)(op + 16 * d) = w; }
    }
}
__device__ __forceinline__ void attn_phase(const Ctx& a, LAS unsigned char* lds, int tid, int wid, int lane, int G, int c) {
    for (int i = 0;; ++i) { const int L = i * G + ((i & 1) ? (G - 1 - c) : c); if (L >= NBATCH * NHEAD * 8) break;
        const int qb = 7 - (L >> 7), bh = L & 127;
        attn_unit(a, lds, bh >> 3, bh & 7, qb, tid, wid, lane); }
}

#define XB_TMO      128
#define XB_XCNT(j)  (256  + 64 * (j))
#define XB_XSUB(j)  (1280 + 64 * (j))
#define XB_XGEN(j)  (2304 + 64 * (j))
#define XB_TOP      3328
#define XB_TOPGEN   3392
#define XCD_BAR_WORDS 3456
#define XB_SPIN_CAP (1u << 18)

__device__ __forceinline__ unsigned xb_ld(unsigned* p)              { return __hip_atomic_load(p, __ATOMIC_RELAXED, __HIP_MEMORY_SCOPE_AGENT); }
__device__ __forceinline__ unsigned xb_add(unsigned* p, unsigned v) { return __hip_atomic_fetch_add(p, v, __ATOMIC_RELAXED, __HIP_MEMORY_SCOPE_AGENT); }
__device__ __forceinline__ unsigned xb_xcc_id() { return (unsigned)__builtin_amdgcn_s_getreg((3 << 11) | 20) & 0xFu; }
#define XB_SPIN(cond, bar) do { unsigned _sp = 0; while (cond) { __builtin_amdgcn_s_sleep(1); \
    if ((++_sp & 255u) == 0u) { if (xb_ld(&(bar)[XB_TMO])) break; if (_sp > XB_SPIN_CAP) { atomicAdd(&(bar)[XB_TMO], 1u); break; } } } } while (0)

struct XcdBarrier {
    unsigned* bar; unsigned x;
    volatile LAS unsigned* st;
};

__device__ __forceinline__ XcdBarrier xcd_barrier_post(unsigned* bar, volatile LAS unsigned* st) {
    XcdBarrier b; b.bar = bar; b.x = xb_xcc_id(); b.st = st;
    if (threadIdx.x == 0) (void)xb_add(&bar[XB_XCNT(b.x)], 1u);
    return b;
}
__device__ __forceinline__ void xcd_barrier_complete(unsigned* bar, unsigned x, unsigned& nloc, unsigned& nx) {
    const unsigned G = gridDim.x * gridDim.y * gridDim.z;
    unsigned sum, cnt, mine, sp = 0u;
    for (;;) {
        sum = 0u; cnt = 0u; mine = 0u;
#pragma unroll
        for (unsigned j = 0; j < 16; ++j) { const unsigned c = xb_ld(&bar[XB_XCNT(j)]); sum += c; cnt += (c > 0u) ? 1u : 0u; mine = (j == x) ? c : mine; }
        if (sum == G) break;
        __builtin_amdgcn_s_sleep(1);
        if ((++sp & 255u) == 0u) { if (xb_ld(&bar[XB_TMO])) break; if (sp > XB_SPIN_CAP) { atomicAdd(&bar[XB_TMO], 1u); break; } }
    }
    nloc = mine > 0u ? mine : 1u; nx = cnt > 0u ? cnt : 1u;
}

__device__ __forceinline__ void xcd_barrier(const XcdBarrier& b) {
    asm volatile("s_waitcnt vmcnt(0)" ::: "memory");
    __syncthreads();
    if (threadIdx.x == 0) {
        unsigned* bar = b.bar;
        __builtin_amdgcn_s_waitcnt(0);
        unsigned nloc = b.st[0], nx = b.st[1];
        if (nloc == 0u) { xcd_barrier_complete(bar, b.x, nloc, nx); b.st[0] = nloc; b.st[1] = nx; }
        const unsigned old = xb_add(&bar[XB_XSUB(b.x)], 1u);
        const unsigned gen = old / nloc;
        if (old + 1u == (gen + 1u) * nloc) {
            __builtin_amdgcn_fence(__ATOMIC_RELEASE, "agent");
            asm volatile("s_waitcnt vmcnt(0)" ::: "memory");
            const unsigned og = xb_add(&bar[XB_TOP], 1u);
            const unsigned tg = og / nx;
            if (og + 1u == (tg + 1u) * nx) xb_add(&bar[XB_TOPGEN], 1u);
            else XB_SPIN(xb_ld(&bar[XB_TOPGEN]) == tg, bar);
            __builtin_amdgcn_fence(__ATOMIC_ACQUIRE, "agent");
            xb_add(&bar[XB_XGEN(b.x)], 1u);
            asm volatile("s_waitcnt vmcnt(0)" ::: "memory");
        } else {
            XB_SPIN(xb_ld(&bar[XB_XGEN(b.x)]) == gen, bar);
            __builtin_amdgcn_fence(__ATOMIC_ACQUIRE, "agent");
            asm volatile("s_waitcnt vmcnt(0)" ::: "memory");
        }
    }
    __syncthreads();
}


template <int MASK> __global__ void __launch_bounds__(512, 2) mega_fwd(Args ka) {
    extern __shared__ __attribute__((aligned(16))) unsigned char lds_raw[];
    LAS unsigned char* lds = (LAS unsigned char*)lds_raw;
    cg::grid_group grid = cg::this_grid();
    volatile LAS unsigned* bst = (volatile LAS unsigned*)(lds + 131072);
    if (threadIdx.x < 2) bst[threadIdx.x] = 0u;
    __syncthreads();
    const XcdBarrier xbar = xcd_barrier_post((unsigned*)(ka.ws + OFF_BAR), bst);
    if (ka.ph_lo == 0) {
        if (threadIdx.x == 0) { long long* tb = (long long*)(ka.ws + OFF_PTRS);
#pragma unroll
            for (int i = 0; i < 26; ++i) tb[i] = (long long)((const unsigned char*)ka.in[i] - ka.ws);
            tb[26] = (long long)((const unsigned char*)ka.out - ka.ws); }
        __syncthreads();
    }
#ifdef DUP_MASK
    int ph = ka.ph_lo - 1, rep = 1;
    for (;;) {
        if (rep == 0 && ph > 0 && ((DUP_MASK >> ((ph - 1) % 11)) & 1)) rep = 1; else { rep = 0; ++ph; }
        if (ph >= ka.ph_hi) break;
        if (ph > 0 && ((ph - 1) % 11 == 6 || (ph - 1) % 11 == 10)) continue;
        if (ph > ka.ph_lo) { if (ph == ka.ph_lo + 1) grid.sync(); else xcd_barrier(xbar); }
#ifdef EXTRA_SYNCS
        for (int es = 0; es < EXTRA_SYNCS; ++es) grid.sync();
#endif
#else
    for (int ph = ka.ph_lo; ph < ka.ph_hi; ++ph) {
        if (ph > 0 && ((ph - 1) % 11 == 6 || (ph - 1) % 11 == 10)) continue;
        if (ph > ka.ph_lo) { if (ph == ka.ph_lo + 1) grid.sync(); else xcd_barrier(xbar); }
#endif
        int tid_o = threadIdx.x; asm volatile("" : "+v"(tid_o));
        const int tid = tid_o, lane = tid & 63, wid = __builtin_amdgcn_readfirstlane(tid >> 6);
        size_t zoff = 0; asm volatile("" : "+s"(zoff));
        unsigned char* ws = ka.ws + zoff;
        const float epsv = __uint_as_float(0x358637bdu + (unsigned)zoff);
        int G = gridDim.x, cu = blockIdx.x; asm volatile("" : "+s"(G), "+s"(cu));
        const Ctx a{ws, (const long long*)(ws + OFF_PTRS), (float*)(ws + ((const long long*)(ws + OFF_PTRS))[26])};
        bf16_t* Wb = (bf16_t*)(ws + WS_W);
        float* ssx = (float*)(ws + WS_SSX); unsigned long long* gran = (unsigned long long*)(ws + WS_GRAN); float* ssq = (float*)(ws + OFF_SSQ); float* sskv = (float*)(ws + OFF_SSKV); float* ssy = (float*)(ws + OFF_SSY);
        const float* rope = (const float*)(ws + OFF_ROPE);
        bf16_t* XY = (bf16_t*)(ws + WS_XY);
        if (ph == 0) { if constexpr ((MASK >> 11) & 1) { init_phase(a, tid, wid, lane, G, cu, epsv); prep_layer(a, 0, lds, tid, wid, lane, G, cu, 0); } continue; }
        const int l = (ph - 1) / 11, sp = (ph - 1) % 11;
        switch (sp) {
        case 0: if constexpr ((MASK >> 0) & 1) {
            Gemm g{XY, Wb + WE_IN, DM, DM, DM, 0, 0}; StaticOrder S; S.init(T_TOK, INP, G, cu);
            EpiIn E{ssx, epsv, (bf16_t*)(ws + WS_CQ), (bf16_t*)(ws + WS_KPE), (bf16_t*)(ws + WS_CKV), (bf16_t*)(ws + WS_UP), (bf16_t*)(ws + WS_GATES), a.inp(I_BGATE) + (size_t)l * 2048, ssq, sskv, rope};
            gemm_phase<EpiIn, StaticOrder, true, true>(lds, g, S, E);
            if (cu >= G / 2) prep_layer(a, l, lds, tid, wid, lane, G, cu, 1);
        } break;
        case 1: if constexpr ((MASK >> 1) & 1) {
            if constexpr ((MASK >> 12) & 1) { Gemm g{(const bf16_t*)(ws + WS_CQ), Wb + WE_UQ, QL, QL, QL, 0, 0}; StaticOrder S; S.init(T_TOK, 768, G, cu);
              EpiQ E{ssq, (bf16_t*)(ws + WS_Q), rope, 0.10206207261596577f * 1.4426950408889634f, epsv};
              gemm_phase<EpiQ, StaticOrder, true, true>(lds, g, S, E); }
            if constexpr ((MASK >> 13) & 1) { Gemm g{(const bf16_t*)(ws + WS_UP), Wb + WE_WST, KS5, 512, 512, (size_t)NCHR * KS5, (size_t)256 * 512}; BatchOrder S; S.init(NCHR, 256, NGRP, G, (cu + G / 2) % G);
              EpiState E{(float*)(ws + WS_SST)};
              gemm_phase<EpiState, BatchOrder, true, true>(lds, g, S, E); }
            if constexpr ((MASK >> 14) & 1) { Gemm g{(const bf16_t*)(ws + WS_CKV), Wb + WE_UKV, KVL, KVL, KVL, 0, 0}; StaticOrder S; S.init(T_TOK, 1024, G, cu);
              EpiKV E{sskv, (bf16_t*)(ws + WS_KN), (bf16_t*)(ws + WS_V), epsv};
              gemm_phase<EpiKV, StaticOrder, true, true>(lds, g, S, E); }
        } break;
        case 2: if constexpr ((MASK >> 2) & 1) {
            carry_phase(a, tid, G, cu);
            attn_phase(a, lds, tid, wid, lane, G, cu);
        } break;
        case 3: if constexpr ((MASK >> 3) & 1) {
            { Gemm g{(const bf16_t*)(ws + WS_O), Wb + WE_OATT, 512, 512, 512, 0, 0}; StaticOrder S; S.init(T_TOK, DM, G, cu);
              EpiOatt E{(const bf16_t*)(ws + WS_GATES), (bf16_t*)(ws + WS_MERGED)};
              gemm_phase<EpiOatt, StaticOrder, true, true>(lds, g, S, E); }
            { Gemm g{(const bf16_t*)(ws + WS_UP), Wb + WE_TV, KS5, KS5, KS5, (size_t)NCHR * KS5, (size_t)512 * KS5}; BatchOrder S; S.init(NCHR, 512, NGRP, G, cu);
              EpiS5 E{(bf16_t*)(ws + WS_YS5)};
              gemm_phase<EpiS5, BatchOrder, true, true>(lds, g, S, E); }
        } break;
        case 4: if constexpr ((MASK >> 4) & 1) {
            Gemm g{(const bf16_t*)(ws + WS_YS5), Wb + WE_GLU, SSMW, SSMW, SSMW, 0, 0}; StaticOrder S; S.init(T_TOK, 2048, G, cu);
            EpiGlu E{(const bf16_t*)(ws + WS_GATES), (bf16_t*)(ws + WS_MERGED)};
            gemm_phase<EpiGlu, StaticOrder, true, true>(lds, g, S, E);
        } break;
        case 5: if constexpr ((MASK >> 5) & 1) {
            Gemm g{(const bf16_t*)(ws + WS_MERGED), Wb + WE_OUT, DM, DM, DM, 0, 0}; StaticOrder S; S.init(T_TOK, DM, G, cu);
            EpiYN E{XY, nullptr, a.inp(I_GMIXPOST) + (size_t)l * DM, gran, ssx, (unsigned)(l * 2 + 1), epsv, (LAS float*)(lds + 131072 + 64)};
            gemm_phase<EpiYN, StaticOrder, true, true>(lds, g, S, E);
        } break;
        case 6: break;
        case 7: if constexpr ((MASK >> 7) & 1) {
            Gemm g{XY, Wb + WE_UP, DM, DM, DM, 0, 0}; StaticOrder S; S.init(T_TOK, 2 * DFF, G, cu);
            EpiUpConv E{ssx, epsv, a.inp(I_CONVW) + (size_t)l * 3 * DFF, a.inp(I_CONVB) + (size_t)l * DFF, (bf16_t*)(ws + WS_VAL), (float*)(ws + WS_GL), (float*)(ws + WS_GF), (float*)(ws + WS_VF), (LAS float*)(lds + 131072 + 64)};
            gemm_phase<EpiUpConv, StaticOrder, true, true>(lds, g, S, E);
        } break;
        case 8: if constexpr ((MASK >> 8) & 1) { conv_fixup_phase(a, l, tid, G, cu);
            if (l + 1 < DEPTH) prep_layer(a, l + 1, lds, tid, wid, lane, G, cu, 0);
        } break;
        case 9: if constexpr ((MASK >> 9) & 1) {
            Gemm g{(const bf16_t*)(ws + WS_VAL), Wb + WE_DOWN, DFF, DFF, DFF, 0, 0}; StaticOrder S; S.init(T_TOK, DM, G, cu);
            EpiYN E{XY, (l + 1 == DEPTH) ? a.out : nullptr, a.inp(I_GFFNPOST) + (size_t)l * DM, gran, ssx, (unsigned)(l * 2 + 2), epsv, (LAS float*)(lds + 131072 + 64)};
            gemm_phase<EpiYN, StaticOrder, true, true>(lds, g, S, E);
        } break;
        case 10: if constexpr ((MASK >> 10) & 1) {
        } break;
        }
    }
}

#ifndef N_LAUNCH_MODE
#define N_LAUNCH_MODE 1
#endif
#ifndef GEMM_MASK_V
#define GEMM_MASK_V 0x7ABB
#endif
constexpr int GEMM_MASK = GEMM_MASK_V, OTHER_MASK = 0xD44;
extern "C" void kernel_launch(void* const* d_in, const int* in_sizes, int n_in, void* d_out, int out_size, void* d_ws, size_t ws_size, hipStream_t stream) {
    static int grid = 0;
    if (grid == 0) {
        if (n_in != 26 || out_size != T_TOK * DM || ws_size < WS_END) { fprintf(stderr, "kernel_launch: unexpected shapes (n_in %d out %d ws %zu)\n", n_in, out_size, ws_size); grid = -1; return; }
        int dev = 0, cus = 0;
        (void)hipGetDevice(&dev); (void)hipDeviceGetAttribute(&cus, hipDeviceAttributeMultiprocessorCount, dev);
#if N_LAUNCH_MODE == 1
        (void)hipFuncSetAttribute((const void*)mega_fwd<0x7FFF>, hipFuncAttributeMaxDynamicSharedMemorySize, LDS_BYTES);
#else
        (void)hipFuncSetAttribute((const void*)mega_fwd<GEMM_MASK>, hipFuncAttributeMaxDynamicSharedMemorySize, LDS_BYTES);
        (void)hipFuncSetAttribute((const void*)mega_fwd<OTHER_MASK>, hipFuncAttributeMaxDynamicSharedMemorySize, LDS_BYTES);
#endif
        grid = cus > 0 ? cus : 256;
        (void)hipGetLastError();
    }
    if (grid < 0) return;
    Args a{};
    for (int i = 0; i < 26; ++i) a.in[i] = (const float*)d_in[i];
    a.out = (float*)d_out; a.ws = (unsigned char*)d_ws;
#if N_LAUNCH_MODE == 1
    a.ph_lo = 0; a.ph_hi = 1 + 11 * DEPTH;
    (void)hipMemsetAsync((char*)d_ws + OFF_BAR, 0, XCD_BAR_WORDS * 4, stream);
    (void)hipMemsetAsync((char*)d_ws + WS_GRAN, 0, GRAN_BYTES, stream);
    void* args[] = {&a};
    hipError_t e = hipLaunchCooperativeKernel((const void*)mega_fwd<0x7FFF>, dim3(grid), dim3(512), args, LDS_BYTES, stream);
    if (e != hipSuccess) fprintf(stderr, "cooperative launch failed: %s (grid %d)\n", hipGetErrorString(e), grid);
#else
    for (int ph = 0; ph < 1 + 11 * DEPTH; ++ph) {
        a.ph_lo = ph; a.ph_hi = ph + 1;
        const int sp = ph == 0 ? 11 : (ph - 1) % 11;
        if ((0x2BB >> sp) & 1) hipLaunchKernelGGL(mega_fwd<GEMM_MASK>, dim3(grid), dim3(512), LDS_BYTES, stream, a);
        else hipLaunchKernelGGL(mega_fwd<OTHER_MASK>, dim3(grid), dim3(512), LDS_BYTES, stream, a);
    }
#endif
}
```
